# Optimizing an MI355X kernel written in HIP

```python
import math
import jax
import jax.numpy as jnp
from jax import lax
import numpy as np

D_MODEL = 2048
BATCH = 8
SEQ = 4096
DEPTH = 2

GRID_W = 64
CTX_LEN = 256
EPS = 1e-6
F32 = jnp.float32

POOL_WIDTH = D_MODEL // 4
POOL_WINDOWS = (2, 4, 8, 16)
POOL_GROUPS = len(POOL_WINDOWS)
POOL_GROUP_W = POOL_WIDTH // POOL_GROUPS
S5_WIDTH = D_MODEL // 4
S5_GROUP_W = 16
S5_GROUPS = S5_WIDTH // S5_GROUP_W
S5_STATE = 64
S5_DT_MIN = 0.001
S5_DT_MAX = 0.1
ATTN_WIDTH = D_MODEL // 2
DIFF_HEADS = 8
DIFF_V_DIM = ATTN_WIDTH // DIFF_HEADS
DIFF_QK_DIM = DIFF_V_DIM // 2
ROPE_PAIRS = DIFF_QK_DIM // 4
ROPE_THETA = 10000.0
Q_BLOCK = 128
N_BRANCH = 3
IN_POOL = 0
IN_S5 = IN_POOL + POOL_WIDTH
IN_Q = IN_S5 + S5_WIDTH
IN_K = IN_Q + ATTN_WIDTH
IN_V = IN_K + ATTN_WIDTH
IN_GATE = IN_V + ATTN_WIDTH
IN_TOTAL = IN_GATE + N_BRANCH * D_MODEL
PEER_HEADS = 8
PEER_N_KEYS = 128
PEER_N_EXPERTS = PEER_N_KEYS * PEER_N_KEYS
PEER_TOPK = 16
PEER_QUERY_DIM = 256
PEER_HALF = PEER_QUERY_DIM // 2
PEER_BLOCK = 128

kernel_name = 'hybrid_pool_s5_diffattn_peer_dit'


def rmsnorm(x, g):
    xf = x.astype(F32)
    y = xf * lax.rsqrt(jnp.mean(xf * xf, axis=-1, keepdims=True) + EPS) * g.astype(F32)
    return y.astype(x.dtype)


def modulate(h, shift, scale):
    return h * (1.0 + scale) + shift


def pool_mix(p, w_pool, scale):
    b, s, _ = p.shape
    pf = p.astype(F32)
    cs = jnp.concatenate([jnp.zeros((b, 1, POOL_WIDTH), F32), jnp.cumsum(pf, axis=1)], axis=1)
    t = jnp.arange(s)
    parts = []
    for g, win in enumerate(POOL_WINDOWS):
        lo = jnp.clip(t - win // 2, 0, s - 1)
        hi = jnp.clip(t + win - 1 - win // 2, 0, s - 1)
        sl = slice(g * POOL_GROUP_W, (g + 1) * POOL_GROUP_W)
        csg = cs[..., sl]
        mean = (jnp.take(csg, hi + 1, axis=1) - jnp.take(csg, lo, axis=1)) / (hi - lo + 1).astype(F32)[:, None]
        parts.append(mean - pf[..., sl])
    d = jnp.stack(parts, axis=2)
    y = jnp.einsum('bsgi,gio->bsgo', d, w_pool.astype(F32)).reshape(b, s, POOL_WIDTH)
    return (y * scale.astype(F32)).astype(p.dtype)


def s5_discretise(a_re, a_im, log_dt, b_re, b_im):
    dt = jnp.exp(log_dt)[:, None]
    mag = jnp.exp(a_re * dt)
    lb_re, lb_im = mag * jnp.cos(a_im * dt), mag * jnp.sin(a_im * dt)
    den = a_re * a_re + a_im * a_im
    coef_re = ((lb_re - 1.0) * a_re + lb_im * a_im) / den
    coef_im = (lb_im * a_re - (lb_re - 1.0) * a_im) / den
    bb_re = coef_re[..., None] * b_re - coef_im[..., None] * b_im
    bb_im = coef_re[..., None] * b_im + coef_im[..., None] * b_re
    return lb_re, lb_im, bb_re, bb_im


def _ssm_combine(e1, e2):
    a1r, a1i, b1r, b1i = e1
    a2r, a2i, b2r, b2i = e2
    return (a1r * a2r - a1i * a2i, a1r * a2i + a1i * a2r,
            a2r * b1r - a2i * b1i + b2r, a2r * b1i + a2i * b1r + b2i)


def s5_states(u, lb_re, lb_im, bb_re, bb_im, reverse, h0_re=None, h0_im=None):
    s = u.shape[1]
    bu_re = jnp.einsum('bsgh,gph->bsgp', u, bb_re)
    bu_im = jnp.einsum('bsgh,gph->bsgp', u, bb_im)
    shape = (1, s) + lb_re.shape
    acc_re, acc_im, s_re, s_im = lax.associative_scan(
        _ssm_combine, (jnp.broadcast_to(lb_re, shape), jnp.broadcast_to(lb_im, shape), bu_re, bu_im),
        axis=1, reverse=reverse)
    if h0_re is not None:
        h0_re, h0_im = h0_re[:, None], h0_im[:, None]
        s_re, s_im = (s_re + acc_re * h0_re - acc_im * h0_im,
                      s_im + acc_re * h0_im + acc_im * h0_re)
    return s_re, s_im


def s5_readout(s_re, s_im, c_re, c_im):
    return jnp.einsum('ghp,bsgp->bsgh', c_re, s_re) - jnp.einsum('ghp,bsgp->bsgh', c_im, s_im)


def s5_glu(y, w_glu):
    g = jax.nn.gelu(y)
    return g * jax.nn.sigmoid(g @ w_glu.astype(F32))


def s5_branch(u_lat, u_ctx, a_re, a_im, log_dt, b_re, b_im, c_re, c_im, d_skip, w_glu, need_ctx):
    dtype = u_lat.dtype
    bsz, s, _ = u_lat.shape
    ul = u_lat.astype(F32).reshape(bsz, s, S5_GROUPS, S5_GROUP_W)
    uc = u_ctx.astype(F32).reshape(bsz, u_ctx.shape[1], S5_GROUPS, S5_GROUP_W)
    dsk = d_skip.astype(F32).reshape(S5_GROUPS, S5_GROUP_W)
    yl = ul * dsk
    yc = uc * dsk
    for dirn in range(2):
        rev = dirn == 1
        end = 0 if rev else -1
        lb_re, lb_im, bb_re, bb_im = s5_discretise(a_re[dirn].astype(F32), a_im[dirn].astype(F32),
                                                   log_dt[dirn].astype(F32), b_re[dirn].astype(F32),
                                                   b_im[dirn].astype(F32))
        cr, ci = c_re[dirn].astype(F32), c_im[dirn].astype(F32)
        sc_re, sc_im = s5_states(uc, lb_re, lb_im, bb_re, bb_im, rev)
        sl_re, sl_im = s5_states(ul, lb_re, lb_im, bb_re, bb_im, rev, sc_re[:, end], sc_im[:, end])
        yl = yl + s5_readout(sl_re, sl_im, cr, ci)
        if need_ctx:
            yc = yc + s5_readout(sc_re, sc_im, cr, ci)
    out_l = s5_glu(yl.reshape(bsz, s, S5_WIDTH), w_glu).astype(dtype)
    out_c = s5_glu(yc.reshape(bsz, u_ctx.shape[1], S5_WIDTH), w_glu).astype(dtype) if need_ctx else None
    return out_l, out_c


def rope1d(x, cos, sin):
    h = x.shape[-1] // 2
    x1, x2 = x[..., :h], x[..., h:]
    cos, sin = cos.astype(x.dtype), sin.astype(x.dtype)
    return jnp.concatenate([x1 * cos - x2 * sin, x1 * sin + x2 * cos], axis=-1)


def axial_rope(x, cos_r, sin_r, cos_c, sin_c):
    half = x.shape[-1] // 2
    return jnp.concatenate([rope1d(x[..., :half], cos_r, sin_r), rope1d(x[..., half:], cos_c, sin_c)], axis=-1)


def split_qk(z):
    b, s, _ = z.shape
    return z.reshape(b, s, DIFF_HEADS, 2, DIFF_QK_DIM).transpose(0, 2, 3, 1, 4)


def split_v(z):
    b, s, _ = z.shape
    return z.reshape(b, s, DIFF_HEADS, DIFF_V_DIM).transpose(0, 2, 1, 3)


def diff_core(q, k, v, lam):
    sc = jnp.einsum('bhcqd,bhckd->bhcqk', q, k, preferred_element_type=F32) * (DIFF_QK_DIM ** -0.5)
    p = jax.nn.softmax(sc, axis=-1)
    a = p[:, :, 0] - lam * p[:, :, 1]
    return jnp.einsum('bhqk,bhkd->bhqd', a.astype(v.dtype), v)


def blocked_diff_attention(q, k, v, lam):
    b, h, _, s, dk = q.shape
    nb = s // Q_BLOCK
    qb = jnp.moveaxis(q.reshape(b, h, 2, nb, Q_BLOCK, dk), 3, 0)
    o = lax.map(lambda qq: diff_core(qq, k, v, lam), qb)
    return jnp.moveaxis(o, 0, 2).reshape(b, h, s, DIFF_V_DIM)


def diff_post(o, g, lam_init):
    b, h, s, dv = o.shape
    o = rmsnorm(o.transpose(0, 2, 1, 3), g) * (1.0 - lam_init)
    return o.reshape(b, s, h * dv)


def merge(gate_pre, y_pool, y_s5, y_attn, wbp, wbs, wba, wo):
    gp, gs, ga = jnp.split(jax.nn.sigmoid(gate_pre), N_BRANCH, axis=-1)
    return (gp * (y_pool @ wbp) + gs * (y_s5 @ wbs) + ga * (y_attn @ wba)) @ wo


def peer_ffn(h, wq, keys, u_tab, v_tab):
    b, s, d = h.shape
    hb = h.reshape((b * s) // PEER_BLOCK, PEER_BLOCK, d)

    def block(ht):
        q = (ht @ wq).reshape(PEER_BLOCK, PEER_HEADS, 2, PEER_HALF)
        sc = jnp.einsum('thcd,hckd->thck', q, keys, preferred_element_type=F32)
        v1, i1 = lax.top_k(sc[:, :, 0], PEER_TOPK)
        v2, i2 = lax.top_k(sc[:, :, 1], PEER_TOPK)
        cand = (v1[..., :, None] + v2[..., None, :]).reshape(PEER_BLOCK, PEER_HEADS, PEER_TOPK * PEER_TOPK)
        top, ci = lax.top_k(cand, PEER_TOPK)
        e = (jnp.take_along_axis(i1, ci // PEER_TOPK, axis=-1) * PEER_N_KEYS
             + jnp.take_along_axis(i2, ci % PEER_TOPK, axis=-1)).reshape(PEER_BLOCK, -1)
        g = jax.nn.softmax(top, axis=-1).reshape(PEER_BLOCK, -1)
        act = jnp.einsum('tkd,td->tk', u_tab[e], ht, preferred_element_type=F32)
        w = (g * jax.nn.gelu(act)).astype(ht.dtype)
        return jnp.einsum('tk,tkd->td', w, v_tab[e])

    return lax.map(block, hb).reshape(b, s, d)


def setup_inputs(seed: int = 0) -> dict:
    key = jax.random.key(seed)
    ks = jax.random.split(key, 40)
    L, D = DEPTH, D_MODEL
    G, P, H = S5_GROUPS, S5_STATE, S5_GROUP_W

    def nrm(k, shape, scale):
        return jax.random.normal(k, shape, F32) * scale

    a_im0 = jnp.broadcast_to(jnp.pi * jnp.arange(P, dtype=F32), (L, 2, G, P))
    return {
        'x': nrm(ks[0], (BATCH, SEQ, D), 1.0),
        'c': nrm(ks[1], (BATCH, D), 1.0),
        'ctx': nrm(ks[2], (BATCH, CTX_LEN, D), 1.0),
        'c_ctx': nrm(ks[3], (D,), 1.0),
        'ada_w': nrm(ks[4], (L, D, 6 * D), 0.5 * D ** -0.5),
        'ada_b': nrm(ks[5], (L, 6 * D), 0.02),
        'norm1_g': 1.0 + nrm(ks[6], (L, D), 0.02),
        'norm2_g': 1.0 + nrm(ks[7], (L, D), 0.02),
        'w_in': nrm(ks[8], (L, D, IN_TOTAL), D ** -0.5),
        'pool_w': nrm(ks[9], (L, POOL_GROUPS, POOL_GROUP_W, POOL_GROUP_W), POOL_GROUP_W ** -0.5),
        'pool_scale': 1.0 + nrm(ks[10], (L, POOL_WIDTH), 0.02),
        's5_a_re': -0.5 + nrm(ks[11], (L, 2, G, P), 0.01),
        's5_a_im': a_im0 + nrm(ks[12], (L, 2, G, P), 0.01),
        's5_log_dt': jax.random.uniform(ks[13], (L, 2, G), F32, math.log(S5_DT_MIN), math.log(S5_DT_MAX)),
        's5_b_re': nrm(ks[14], (L, 2, G, P, H), (2 * H) ** -0.5),
        's5_b_im': nrm(ks[15], (L, 2, G, P, H), (2 * H) ** -0.5),
        's5_c_re': nrm(ks[16], (L, 2, G, H, P), (2 * P) ** -0.5),
        's5_c_im': nrm(ks[17], (L, 2, G, H, P), (2 * P) ** -0.5),
        's5_d': nrm(ks[18], (L, S5_WIDTH), 1.0),
        's5_glu_w': nrm(ks[19], (L, S5_WIDTH, S5_WIDTH), S5_WIDTH ** -0.5),
        'diff_lq1': nrm(ks[20], (L, DIFF_QK_DIM), 0.1),
        'diff_lk1': nrm(ks[21], (L, DIFF_QK_DIM), 0.1),
        'diff_lq2': nrm(ks[22], (L, DIFF_QK_DIM), 0.1),
        'diff_lk2': nrm(ks[23], (L, DIFF_QK_DIM), 0.1),
        'diff_subln_g': 1.0 + nrm(ks[24], (L, DIFF_V_DIM), 0.02),
        'w_branch_pool': nrm(ks[25], (L, POOL_WIDTH, D), POOL_WIDTH ** -0.5),
        'w_branch_s5': nrm(ks[26], (L, S5_WIDTH, D), S5_WIDTH ** -0.5),
        'w_branch_attn': nrm(ks[27], (L, ATTN_WIDTH, D), ATTN_WIDTH ** -0.5),
        'w_out': nrm(ks[28], (L, D, D), D ** -0.5),
        'peer_wq': nrm(ks[29], (L, D, PEER_HEADS * PEER_QUERY_DIM), D ** -0.5),
        'peer_keys': nrm(ks[30], (L, PEER_HEADS, 2, PEER_N_KEYS, PEER_HALF), PEER_HALF ** -0.5),
        'peer_u': nrm(ks[31], (L, PEER_N_EXPERTS, D), D ** -0.5),
        'peer_v': nrm(ks[32], (L, PEER_N_EXPERTS, D), 1.0),
        'final_g': 1.0 + nrm(ks[33], (D,), 0.02),
    }


def reference(x, c, ctx, c_ctx, ada_w, ada_b, norm1_g, norm2_g, w_in, pool_w, pool_scale,
              s5_a_re, s5_a_im, s5_log_dt, s5_b_re, s5_b_im, s5_c_re, s5_c_im, s5_d, s5_glu_w,
              diff_lq1, diff_lk1, diff_lq2, diff_lk2, diff_subln_g,
              w_branch_pool, w_branch_s5, w_branch_attn, w_out,
              peer_wq, peer_keys, peer_u, peer_v, final_g):
    b, s, d = x.shape
    rows = s // GRID_W
    row_pos = jnp.repeat(jnp.arange(rows, dtype=F32), GRID_W)
    col_pos = jnp.tile(jnp.arange(GRID_W, dtype=F32), rows)
    freqs = ROPE_THETA ** (-jnp.arange(ROPE_PAIRS, dtype=F32) / ROPE_PAIRS)
    ang_r = row_pos[:, None] * freqs
    ang_c = col_pos[:, None] * freqs
    rope = (jnp.cos(ang_r), jnp.sin(ang_r), jnp.cos(ang_c), jnp.sin(ang_c))

    silu_lat = jax.nn.silu(c)[:, None, :]
    silu_ctx = jax.nn.silu(c_ctx)[None, None, :]
    xl, xc = x, ctx
    for l in range(DEPTH):
        need_ctx = l < DEPTH - 1
        mod_l = jnp.split(silu_lat @ ada_w[l] + ada_b[l], 6, axis=-1)
        mod_c = jnp.split(silu_ctx @ ada_w[l] + ada_b[l], 6, axis=-1)
        w = w_in[l]
        hl = modulate(rmsnorm(xl, norm1_g[l]), mod_l[0], mod_l[1])
        hc = modulate(rmsnorm(xc, norm1_g[l]), mod_c[0], mod_c[1])

        lam_init = 0.8 - 0.6 * math.exp(-0.3 * l)
        lam = (jnp.exp(jnp.sum(diff_lq1[l] * diff_lk1[l]).astype(F32))
               - jnp.exp(jnp.sum(diff_lq2[l] * diff_lk2[l]).astype(F32)) + lam_init)
        q_l = axial_rope(split_qk(hl @ w[:, IN_Q:IN_K]), *rope)
        k_l = axial_rope(split_qk(hl @ w[:, IN_K:IN_V]), *rope)
        v_l = split_v(hl @ w[:, IN_V:IN_GATE])
        k_c = split_qk(hc @ w[:, IN_K:IN_V])
        v_c = split_v(hc @ w[:, IN_V:IN_GATE])
        k_all = jnp.concatenate([k_l, k_c], axis=3)
        v_all = jnp.concatenate([v_l, v_c], axis=2)
        a_l = diff_post(blocked_diff_attention(q_l, k_all, v_all, lam), diff_subln_g[l], lam_init)

        s_l, s_c = s5_branch(hl @ w[:, IN_S5:IN_Q], hc @ w[:, IN_S5:IN_Q], s5_a_re[l], s5_a_im[l],
                             s5_log_dt[l], s5_b_re[l], s5_b_im[l], s5_c_re[l], s5_c_im[l], s5_d[l],
                             s5_glu_w[l], need_ctx)

        p_l = pool_mix(hl @ w[:, IN_POOL:IN_S5], pool_w[l], pool_scale[l])

        y_l = merge(hl @ w[:, IN_GATE:IN_TOTAL], p_l, s_l, a_l,
                    w_branch_pool[l], w_branch_s5[l], w_branch_attn[l], w_out[l])
        xl = xl + mod_l[2] * y_l
        xl = xl + mod_l[5] * peer_ffn(modulate(rmsnorm(xl, norm2_g[l]), mod_l[3], mod_l[4]),
                                      peer_wq[l], peer_keys[l], peer_u[l], peer_v[l])

        if need_ctx:
            q_c = split_qk(hc @ w[:, IN_Q:IN_K])
            a_c = diff_post(diff_core(q_c, k_c, v_c, lam), diff_subln_g[l], lam_init)
            p_c = pool_mix(hc @ w[:, IN_POOL:IN_S5], pool_w[l], pool_scale[l])
            y_c = merge(hc @ w[:, IN_GATE:IN_TOTAL], p_c, s_c, a_c,
                        w_branch_pool[l], w_branch_s5[l], w_branch_attn[l], w_out[l])
            xc = xc + mod_c[2] * y_c
            xc = xc + mod_c[5] * peer_ffn(modulate(rmsnorm(xc, norm2_g[l]), mod_c[3], mod_c[4]),
                                          peer_wq[l], peer_keys[l], peer_u[l], peer_v[l])
    return rmsnorm(xl, final_g)
```

```cpp
#include <hip/hip_runtime.h>
#include <stdint.h>
#include <stdio.h>

#ifndef ONE_LAUNCH
#define ONE_LAUNCH 1
#endif
#define PEER_USC 90.f
#define PEER_VSC 2.f
#ifndef GATES_FP4
#define GATES_FP4 1
#endif
#define G4_HS 1.5f
#define G4_WS 90.f

typedef unsigned short u16;
typedef __attribute__((ext_vector_type(8))) short bf16x8;
typedef __attribute__((ext_vector_type(4))) float f32x4;
typedef __attribute__((ext_vector_type(2))) __bf16 bf16x2v;
typedef __attribute__((ext_vector_type(4))) unsigned u32x4;
typedef __attribute__((ext_vector_type(2))) float f32x2;
typedef __attribute__((ext_vector_type(2))) _Float16 h16x2;
#define CVT4H(p, sel) __builtin_bit_cast(h16x2, __builtin_amdgcn_cvt_scalef32_pk_f16_fp4((p), 1.0f, (sel)))
typedef __attribute__((ext_vector_type(8))) int v8i;
typedef __attribute__((ext_vector_type(4))) int v4i;

constexpr int D = 2048, NB = 8, SEQ = 4096, CTXL = 256;
constexpr int RL = NB * SEQ, RC = NB * CTXL, R = RL + RC;
constexpr int NIN = 10240, SK = SEQ + CTXL;
constexpr int NPL = 14;
constexpr int NPHASE = 1 + 2 * NPL;
constexpr int S5L = 32, S5N = 1280, S5K = 768;
constexpr int LDS_BYTES = 139264;
constexpr int BAR_LDS_OFF = 131072;

constexpr size_t MB = 1ull << 20;
constexpr size_t al(size_t x) { return (x + 255) & ~(size_t)255; }
constexpr size_t WS_CTL = 0;
constexpr size_t WS_MODS = 65536;
constexpr size_t WS_ROPE = WS_MODS + al(2ull * 9 * 12288 * 4);
constexpr size_t WS_XC = WS_ROPE + al(64 * 16 * 8);
constexpr size_t WS_WIN = WS_XC + al((size_t)RC * D * 4);
constexpr size_t WS_WBR = WS_WIN + al(2ull * NIN * D * 2);
constexpr size_t WS_WOUT = WS_WBR + al(2ull * D * D * 2);
constexpr size_t WS_WPK = WS_WOUT + al(2ull * D * D * 2);
constexpr size_t WS_WQ16 = WS_WPK + al(2ull * D * D * 2);
constexpr size_t WS_KPAD = WS_WQ16 + al(2ull * D * D * 2);
constexpr size_t WS_WGLU = WS_KPAD + al(2ull * 8 * 256 * 256 * 2);
constexpr size_t WS_WPOOL = WS_WGLU + al(2ull * 512 * 512 * 2);
constexpr size_t WS_AC = WS_WPOOL + al(2ull * 512 * 512 * 2);
constexpr size_t WS_AE = WS_AC + al(32ull * 512 * S5K * 2);
constexpr size_t WS_H = WS_AE + al(32ull * 256 * 512 * 2);
constexpr size_t WS_PD = WS_H;
constexpr size_t WS_UT = WS_PD + al((size_t)R * 512 * 2);
constexpr size_t WS_YG = WS_UT + al(32ull * S5N * S5K * 2);
constexpr size_t WS_PROJ = WS_H + al((size_t)R * D * 2);
constexpr size_t WS_POOLP = WS_PROJ;
constexpr size_t WS_S5U = WS_POOLP + al((size_t)R * 512 * 2);
constexpr size_t WS_Q = WS_S5U + al((size_t)R * 512 * 2);
constexpr size_t WS_K = WS_Q + al((size_t)R * 1024 * 2);
constexpr size_t WS_VT = WS_K + al((size_t)R * 1024 * 2);
constexpr size_t WS_GATE = WS_VT + al((size_t)NB * 1024 * SK * 2);
constexpr size_t WS_YPOOL = WS_GATE + al((size_t)R * 6144 * 2);
constexpr size_t WS_YS5 = WS_YPOOL + al((size_t)R * 512 * 2);
constexpr size_t WS_YATT = WS_YS5 + al((size_t)R * 512 * 2);
constexpr size_t WS_END = WS_YATT + al((size_t)R * 1024 * 2);
constexpr size_t WS_XB = WS_GATE + al((size_t)R * 6144);
static_assert(WS_XB + (size_t)RL * D * 2 <= WS_YPOOL, "bf16 residual stream fits behind the fp8 gates");
constexpr size_t WS_PERM = WS_WIN + 2ull * NIN * D;
constexpr size_t WS_W4 = WS_PERM + 262144;
static_assert(WS_W4 + 2ull * 6144 * 1024 <= WS_WBR, "permuted modulation vectors and fp4 gate weights fit behind the fp8 in-projection weights");
constexpr size_t WS_H4 = WS_XB + al((size_t)RL * D * 2);
static_assert(WS_H4 + (size_t)R * 1024 <= WS_YPOOL, "fp4 h fits behind the bf16 residual stream");
constexpr size_t WS_E = WS_POOLP;
constexpr size_t WS_SCORES = WS_GATE;
constexpr size_t WS_EL = WS_POOLP;
constexpr size_t WS_GL = WS_S5U;
constexpr size_t WS_U16 = WS_Q;
constexpr size_t WS_V16 = WS_K;
static_assert(32ull * S5N * 256 * 4 <= 2 * al((size_t)R * 512 * 2), "E fits");
static_assert(16384ull * 2048 * 2 <= al((size_t)R * 1024 * 2), "peer table fits");
static_assert((size_t)R * 4096 <= WS_END - WS_YPOOL, "fp8 branch outputs + merged fit");
static_assert((size_t)R * 512 * 2 + 32ull * S5N * S5K * 2 + (size_t)R * 512 * 2 <= (size_t)R * D * 2, "PD/UT/YG fit in H");

#define XB_TMO      128
#define XB_XCNT(j)  (256  + 64 * (j))
#define XB_XSUB(j)  (1280 + 64 * (j))
#define XB_XGEN(j)  (2304 + 64 * (j))
#define XB_TOP      3328
#define XB_TOPGEN   3392
#define XCD_BAR_WORDS 3456
#define XB_SPIN_CAP (1u << 20)
#define LAS __attribute__((address_space(3)))
__device__ __forceinline__ unsigned xb_ld(unsigned* p)              { return __hip_atomic_load(p, __ATOMIC_RELAXED, __HIP_MEMORY_SCOPE_AGENT); }
__device__ __forceinline__ unsigned xb_add(unsigned* p, unsigned v) { return __hip_atomic_fetch_add(p, v, __ATOMIC_RELAXED, __HIP_MEMORY_SCOPE_AGENT); }
__device__ __forceinline__ unsigned xb_xcc_id() { return (unsigned)__builtin_amdgcn_s_getreg((3 << 11) | 20) & 0xFu; }
#define XB_SPIN(cond, bar) do { unsigned _sp = 0; while (cond) { __builtin_amdgcn_s_sleep(1); \
    if ((++_sp & 255u) == 0u) { if (xb_ld(&(bar)[XB_TMO])) break; if (_sp > XB_SPIN_CAP) { atomicAdd(&(bar)[XB_TMO], 1u); break; } } } } while (0)
struct XcdBarrier { unsigned* bar; unsigned x; volatile LAS unsigned* st; };
__device__ __forceinline__ XcdBarrier xcd_barrier_post(unsigned* bar, volatile LAS unsigned* st) {
    XcdBarrier b; b.bar = bar; b.x = xb_xcc_id(); b.st = st;
    if (threadIdx.x == 0) (void)xb_add(&bar[XB_XCNT(b.x)], 1u);
    return b;
}
__device__ __forceinline__ void xcd_barrier_complete(unsigned* bar, unsigned x, unsigned& nloc, unsigned& nx) {
    const unsigned G = gridDim.x * gridDim.y * gridDim.z;
    unsigned sum, cnt, mine, sp = 0u;
    for (;;) {
        sum = 0u; cnt = 0u; mine = 0u;
#pragma unroll
        for (unsigned j = 0; j < 16; ++j) { const unsigned c = xb_ld(&bar[XB_XCNT(j)]); sum += c; cnt += (c > 0u) ? 1u : 0u; mine = (j == x) ? c : mine; }
        if (sum == G) break;
        __builtin_amdgcn_s_sleep(1);
        if ((++sp & 255u) == 0u) { if (xb_ld(&bar[XB_TMO])) break; if (sp > XB_SPIN_CAP) { atomicAdd(&bar[XB_TMO], 1u); break; } }
    }
    nloc = mine > 0u ? mine : 1u; nx = cnt > 0u ? cnt : 1u;
}
__device__ __forceinline__ void xcd_barrier(const XcdBarrier& b) {
    asm volatile("s_waitcnt vmcnt(0)" ::: "memory");
    __syncthreads();
    if (threadIdx.x == 0) {
        unsigned* bar = b.bar;
        __builtin_amdgcn_s_waitcnt(0);
        unsigned nloc = b.st[0], nx = b.st[1];
        if (nloc == 0u) { xcd_barrier_complete(bar, b.x, nloc, nx); b.st[0] = nloc; b.st[1] = nx; }
        const unsigned old = xb_add(&bar[XB_XSUB(b.x)], 1u);
        const unsigned gen = old / nloc;
        if (old + 1u == (gen + 1u) * nloc) {
            __builtin_amdgcn_fence(__ATOMIC_RELEASE, "agent");
            asm volatile("s_waitcnt vmcnt(0)" ::: "memory");
            const unsigned og = xb_add(&bar[XB_TOP], 1u);
            const unsigned tg = og / nx;
            if (og + 1u == (tg + 1u) * nx) xb_add(&bar[XB_TOPGEN], 1u);
            else XB_SPIN(xb_ld(&bar[XB_TOPGEN]) == tg, bar);
            __builtin_amdgcn_fence(__ATOMIC_ACQUIRE, "agent");
            xb_add(&bar[XB_XGEN(b.x)], 1u);
            asm volatile("s_waitcnt vmcnt(0)" ::: "memory");
        } else {
            XB_SPIN(xb_ld(&bar[XB_XGEN(b.x)]) == gen, bar);
            __builtin_amdgcn_fence(__ATOMIC_ACQUIRE, "agent");
            asm volatile("s_waitcnt vmcnt(0)" ::: "memory");
        }
    }
    __syncthreads();
}

__device__ __forceinline__ unsigned cvtpk(float lo, float hi) { unsigned r; asm("v_cvt_pk_bf16_f32 %0, %1, %2" : "=v"(r) : "v"(lo), "v"(hi)); return r; }
__device__ __forceinline__ float bflo(unsigned u) { return __uint_as_float(u << 16); }
__device__ __forceinline__ float bfhi(unsigned u) { return __uint_as_float(u & 0xffff0000u); }
__device__ __forceinline__ float sigmoidf_(float x) { return __builtin_amdgcn_rcpf(1.f + __builtin_amdgcn_exp2f(-1.4426950408889634f * x)); }
__device__ __forceinline__ float gelu_tanh(float x) { const float u = 0.7978845608028654f * (x + 0.044715f * x * x * x); return x * __builtin_amdgcn_rcpf(1.f + __builtin_amdgcn_exp2f(-2.885390081777927f * u)); }
__device__ __forceinline__ float dot2bf(unsigned a, unsigned b, float c) { return __builtin_amdgcn_fdot2_f32_bf16(__builtin_bit_cast(bf16x2v, a), __builtin_bit_cast(bf16x2v, b), c, false); }
__device__ __forceinline__ unsigned pack4f8(float a, float b, float c, float d) { int x = __builtin_amdgcn_cvt_pk_fp8_f32(a, b, 0, false); x = __builtin_amdgcn_cvt_pk_fp8_f32(c, d, x, true); return (unsigned)x; }
__device__ __forceinline__ uint2 pack4(f32x4 v) { uint2 r; r.x = cvtpk(v[0], v[1]); r.y = cvtpk(v[2], v[3]); return r; }
__device__ __forceinline__ f32x4 unpack4(uint2 u) { f32x4 r; r[0] = bflo(u.x); r[1] = bfhi(u.x); r[2] = bflo(u.y); r[3] = bfhi(u.y); return r; }

__device__ __forceinline__ int otid() { int t = threadIdx.x; asm volatile("" : "+v"(t)); return t; }
#define PH_TID const int tid = otid(), lane = tid & 63, wave = tid >> 6; (void)lane; (void)wave;

struct Params {
    const float* in[34];
    float* out;
    unsigned char* ws;
    int ph_lo, ph_hi;
};

__device__ __forceinline__ const float* pin(int i) {
    const __attribute__((address_space(4))) char* kp = (const __attribute__((address_space(4))) char*)__builtin_amdgcn_kernarg_segment_ptr();
    asm volatile("" : "+s"(kp));
    return *(const float* const __attribute__((address_space(4)))*)(kp + i * 8);
}

constexpr int BK = 64, HALF = 128, HT = HALF * BK;
__device__ __forceinline__ int lds_byte(int r, int c) {
    int st = (r >> 4) * 2 + (c >> 5), rr = r & 15, cc = c & 31, ob = rr * 64 + cc * 2;
    return st * 1024 + (ob ^ (((ob >> 9) & 1) << 5));
}
__device__ __forceinline__ void stage_rc(int b, int& Rr, int& Cc) {
    int st = b / 1024, sb = b % 1024, swz = sb ^ (((sb >> 9) & 1) << 5);
    Rr = (st >> 1) * 16 + swz / 64; Cc = (st & 1) * 32 + (swz % 64) / 2;
}
typedef f32x4 Acc[2][2][4][2];
#define EPI_LOOP for (int ai = 0; ai < 2; ++ai) for (int bj = 0; bj < 2; ++bj) for (int m = 0; m < 4; ++m) for (int n = 0; n < 2; ++n)

template <int F8, class Epi>
__device__ __forceinline__ void gemm_tile_acc(const u16* __restrict__ Pm, int ldp, const u16* __restrict__ Qm, int ldq, int K, u16* shm, Acc& acc, Epi& epi) {
#define SA(b, h) (shm + ((b) * 2 + (h)) * HT)
#define SB(b, h) (shm + (4 + (b) * 2 + (h)) * HT)
#define STAGE_X(T, PP, BASE, LD, VOFF, br, kt) do { const char* _g = (const char*)(BASE) + ((size_t)(br) * (LD) + (size_t)(kt) * BK) * 2; \
      __builtin_amdgcn_global_load_lds((const unsigned*)(_g + (VOFF)), (unsigned*)((char*)(PP) + (T) * 16), 16, 0, 0); \
      __builtin_amdgcn_global_load_lds((const unsigned*)(_g + (size_t)(LD) * 128 + (VOFF)), (unsigned*)((char*)(PP) + (T) * 16 + 8192), 16, 0, 0); } while (0)
#define STAGE_A(PP, br, kt) STAGE_X(t0_, PP, Pm, ldp, voffA, br, kt)
#define STAGE_B(PP, br, kt) STAGE_X(t0_, PP, Qm, ldq, voffB, br, kt)
#define LDA(dst, b, h) for (int m = 0; m < 4; ++m) \
    dst[m] = __builtin_shufflevector(*reinterpret_cast<const v4i*>((char*)SA(b, h) + lds_byte(wr * 64 + m * 16 + fr, fq * 8)), \
                                     *reinterpret_cast<const v4i*>((char*)SA(b, h) + lds_byte(wr * 64 + m * 16 + fr, 32 + fq * 8)), 0, 1, 2, 3, 4, 5, 6, 7)
#define LDB(dst, b, h) for (int n = 0; n < 2; ++n) \
    dst[n] = __builtin_shufflevector(*reinterpret_cast<const v4i*>((char*)SB(b, h) + lds_byte(wc * 32 + n * 16 + fr, fq * 8)), \
                                     *reinterpret_cast<const v4i*>((char*)SB(b, h) + lds_byte(wc * 32 + n * 16 + fr, 32 + fq * 8)), 0, 1, 2, 3, 4, 5, 6, 7)
#define FLO(x) __builtin_bit_cast(bf16x8, __builtin_shufflevector(x, x, 0, 1, 2, 3))
#define FHI(x) __builtin_bit_cast(bf16x8, __builtin_shufflevector(x, x, 4, 5, 6, 7))
#define MMA(ai, bj, At, Bt) do { __builtin_amdgcn_s_setprio(1); \
    if (F8 == 1) { for (int m = 0; m < 4; ++m) for (int n = 0; n < 2; ++n) \
      asm("v_mfma_f32_16x16x128_f8f6f4 %0, %1, %2, %0" : "+v"(acc[ai][bj][m][n]) : "v"(At[m]), "v"(Bt[n])); } \
    else if (F8 == 2) { for (int m = 0; m < 4; ++m) for (int n = 0; n < 2; ++n) \
      asm("v_mfma_f32_16x16x128_f8f6f4 %0, %1, %2, %0 cbsz:4 blgp:4" : "+v"(acc[ai][bj][m][n]) : "v"(__builtin_shufflevector(At[m], At[m], 0, 1, 2, 3)), "v"(__builtin_shufflevector(Bt[n], Bt[n], 0, 1, 2, 3))); \
      for (int m = 0; m < 4; ++m) for (int n = 0; n < 2; ++n) \
      asm("v_mfma_f32_16x16x128_f8f6f4 %0, %1, %2, %0 cbsz:4 blgp:4" : "+v"(acc[ai][bj][m][n]) : "v"(__builtin_shufflevector(At[m], At[m], 4, 5, 6, 7)), "v"(__builtin_shufflevector(Bt[n], Bt[n], 4, 5, 6, 7))); } \
    else { for (int m = 0; m < 4; ++m) for (int n = 0; n < 2; ++n) { \
      acc[ai][bj][m][n] = __builtin_amdgcn_mfma_f32_16x16x32_bf16(FLO(At[m]), FLO(Bt[n]), acc[ai][bj][m][n], 0, 0, 0); \
      acc[ai][bj][m][n] = __builtin_amdgcn_mfma_f32_16x16x32_bf16(FHI(At[m]), FHI(Bt[n]), acc[ai][bj][m][n], 0, 0, 0); } } \
    __builtin_amdgcn_s_setprio(0); } while (0)
#define WAIT_V(n) asm volatile("s_waitcnt vmcnt(" #n ")" ::: "memory")
#define WAIT_L(n) asm volatile("s_waitcnt lgkmcnt(" #n ")" ::: "memory")
#define BAR __builtin_amdgcn_s_barrier()
#define SCHED __builtin_amdgcn_sched_barrier(0)
    const int t0_ = otid();
    int wid = t0_ >> 6, lane = t0_ & 63, wr = wid >> 2, wc = wid & 3, fr = lane & 15, fq = lane >> 4;
    unsigned voffA, voffB;
    { int _r, _c; stage_rc(t0_ * 16, _r, _c); voffA = (unsigned)(_r * ldp + _c) * 2u; voffB = (unsigned)(_r * ldq + _c) * 2u; }
    v8i At[4], B0[2], B1[2];
    const int nt = K / BK;
    STAGE_B(SB(0, 0), 0, 0); STAGE_A(SA(0, 0), 0, 0);
    STAGE_B(SB(0, 1), HALF, 0); STAGE_A(SA(0, 1), HALF, 0);
    if (wr == 1) BAR;
    WAIT_V(4); BAR;
    STAGE_B(SB(1, 0), 0, 1); STAGE_A(SA(1, 0), 0, 1); STAGE_B(SB(1, 1), HALF, 1);
    WAIT_V(6); BAR;
    for (int t = 0; t < nt - 2; t += 2) {
        LDB(B0, 0, 0); SCHED; LDA(At, 0, 0); STAGE_A(SA(1, 1), HALF, t + 1);
        WAIT_L(8); BAR; WAIT_L(0); MMA(0, 0, At, B0); BAR; SCHED;
        LDB(B1, 0, 1); STAGE_B(SB(0, 0), 0, t + 2);
        BAR; WAIT_L(0); MMA(0, 1, At, B1); BAR;
        LDA(At, 0, 1); STAGE_A(SA(0, 0), 0, t + 2);
        BAR; WAIT_L(0); MMA(1, 0, At, B0); BAR; SCHED;
        STAGE_B(SB(0, 1), HALF, t + 2);
        WAIT_V(6); BAR; MMA(1, 1, At, B1); BAR;
        LDB(B0, 1, 0); SCHED; LDA(At, 1, 0); STAGE_A(SA(0, 1), HALF, t + 2);
        WAIT_L(8); BAR; WAIT_L(0); MMA(0, 0, At, B0); BAR; SCHED;
        LDB(B1, 1, 1); STAGE_B(SB(1, 0), 0, t + 3);
        BAR; WAIT_L(0); MMA(0, 1, At, B1); BAR;
        LDA(At, 1, 1); STAGE_A(SA(1, 0), 0, t + 3);
        BAR; WAIT_L(0); MMA(1, 0, At, B0); BAR; SCHED;
        STAGE_B(SB(1, 1), HALF, t + 3);
        WAIT_V(6); BAR; MMA(1, 1, At, B1); BAR;
    }
    int tz = threadIdx.x; asm volatile("" : "+v"(tz)); wid = tz >> 6; lane = tz & 63; wr = wid >> 2; wc = wid & 3; fr = lane & 15; fq = lane >> 4;
    { int _r, _c; stage_rc(tz * 16, _r, _c); voffA = (unsigned)(_r * ldp + _c) * 2u; }
    { LDB(B0, 0, 0); WAIT_V(0); LDA(At, 0, 0); STAGE_X(tz, SA(1, 1), Pm, ldp, voffA, HALF, nt - 1);
      BAR; WAIT_L(0); MMA(0, 0, At, B0); BAR;
      LDB(B1, 0, 1); BAR; WAIT_L(0); MMA(0, 1, At, B1); BAR;
      LDA(At, 0, 1); WAIT_V(4); BAR; WAIT_L(0); MMA(1, 0, At, B0); MMA(1, 1, At, B1); BAR; }
    { LDB(B0, 1, 0); LDA(At, 1, 0); WAIT_V(2); BAR; WAIT_L(0); MMA(0, 0, At, B0); BAR;
      LDB(B1, 1, 1); WAIT_V(0); BAR; WAIT_L(0); MMA(0, 1, At, B1); BAR;
      LDA(At, 1, 1); BAR; WAIT_L(0); MMA(1, 0, At, B0); MMA(1, 1, At, B1); BAR; }
    if (wr == 0) BAR;
    if (F8) asm volatile("s_nop 7\n\ts_nop 7\n\ts_nop 7" ::: "memory");
    epi(acc, wr, wc, fr, fq);
    __syncthreads();
#undef SA
#undef SB
#undef STAGE_X
#undef STAGE_A
#undef STAGE_B
#undef LDA
#undef LDB
#undef MMA
#undef FLO
#undef FHI
}
template <int F8, class Epi>
__device__ __forceinline__ void gemm_tile(const u16* __restrict__ Pm, int ldp, const u16* __restrict__ Qm, int ldq, int K, u16* shm, Epi& epi) {
    Acc acc = {}; gemm_tile_acc<F8>(Pm, ldp, Qm, ldq, K, shm, acc, epi);
}
#define EPI_LOFF(ld, es) ((unsigned)(((wc * 32 + fr) * (ld) + wr * 64 + fq * 4) * (es)))
#define EPI_UOFF(ld, es) ((size_t)(((bj * 128 + n * 16) * (ld) + ai * 128 + m * 16) * (es)))
#define EPI_ILOFF(es) ((unsigned)((wr * 64 + fq * 4) * (es)))
#define EPI_IUOFF(es) ((size_t)((ai * 128 + m * 16) * (es)))
#define TR4(p0, p1, p2, p3) do { \
        { const auto x_ = __builtin_amdgcn_permlane32_swap(p0, p2, false, false); p0 = x_[0]; p2 = x_[1]; } \
        { const auto x_ = __builtin_amdgcn_permlane32_swap(p1, p3, false, false); p1 = x_[0]; p3 = x_[1]; } \
        { const auto x_ = __builtin_amdgcn_permlane16_swap(p0, p1, false, false); p0 = x_[0]; p1 = x_[1]; } \
        { const auto x_ = __builtin_amdgcn_permlane16_swap(p2, p3, false, false); p2 = x_[0]; p3 = x_[1]; } } while (0)
#define EPI_LOOP3 for (int ai = 0; ai < 2; ++ai) for (int bj = 0; bj < 2; ++bj) for (int n = 0; n < 2; ++n)
#define EPI_UOFF3(ld, es) ((size_t)(((bj * 128 + n * 16) * (ld) + ai * 128) * (es)))
#define EPI_LOFF16(ld, es) ((unsigned)(((wc * 32 + fr) * (ld) + wr * 64 + fq * 16) * (es)))
#define ST16x2(ptr, q0, q1, q2, q3) do { unsigned l0_ = (q0).x, l1_ = (q1).x, l2_ = (q2).x, l3_ = (q3).x, h0_ = (q0).y, h1_ = (q1).y, h2_ = (q2).y, h3_ = (q3).y; \
        TR4(l0_, l1_, l2_, l3_); TR4(h0_, h1_, h2_, h3_); \
        *(u32x4*)(ptr) = (u32x4){l0_, h0_, l1_, h1_}; *(u32x4*)((char*)(ptr) + 16) = (u32x4){l2_, h2_, l3_, h3_}; } while (0)
#define LD16x2(ptr, q0, q1, q2, q3) do { const u32x4 A_ = *(const u32x4*)(ptr), B_ = *(const u32x4*)((const char*)(ptr) + 16); \
        unsigned l0_ = A_[0], h0_ = A_[1], l1_ = A_[2], h1_ = A_[3], l2_ = B_[0], h2_ = B_[1], l3_ = B_[2], h3_ = B_[3]; \
        TR4(l0_, l1_, l2_, l3_); TR4(h0_, h1_, h2_, h3_); \
        (q0).x = l0_; (q0).y = h0_; (q1).x = l1_; (q1).y = h1_; (q2).x = l2_; (q2).y = h2_; (q3).x = l3_; (q3).y = h3_; } while (0)

struct EpiG1 {
    int kind;
    void* out; int ldo;
    bool lat; int t0;
    const float2* rope; float qscale; float wsc;
    __device__ __forceinline__ void operator()(Acc& acc, int wr, int wc, int fr, int fq) {
        const bool f8 = (kind != 0);
        const unsigned loff = f8 ? EPI_LOFF(ldo, 1) : EPI_LOFF(ldo, 2);
#pragma unroll
        for (int bj = 0; bj < 2; ++bj)
#pragma unroll
        for (int n = 0; n < 2; ++n) {
            const int j = bj * 128 + wc * 32 + n * 16 + fr;
            const int t = t0 + j, pr = t >> 6, pc = t & 63;
#pragma unroll
            for (int ai = 0; ai < 2; ++ai) {
                f32x4 v0 = acc[ai][bj][0][n] * wsc, v1 = acc[ai][bj][1][n] * wsc, v2 = acc[ai][bj][2][n] * wsc, v3 = acc[ai][bj][3][n] * wsc;
                if ((kind == 1 || kind == 2) && lat) {
#pragma unroll
                    for (int e = 0; e < 4; ++e) {
                        const float2 cr = rope[pr * 16 + fq * 4 + e], cc = rope[pc * 16 + fq * 4 + e];
                        const float a1 = v0[e], a2 = v1[e], b1 = v2[e], b2 = v3[e];
                        v0[e] = a1 * cr.x - a2 * cr.y; v1[e] = a1 * cr.y + a2 * cr.x;
                        v2[e] = b1 * cc.x - b2 * cc.y; v3[e] = b1 * cc.y + b2 * cc.x;
                    }
                }
                if (kind == 3) {
                    const float c1 = -1.4426950408889634f * wsc, c0 = 0.0078125f;
#pragma unroll
                    for (int e = 0; e < 4; ++e) {
                        v0[e] = __builtin_amdgcn_rcpf(c0 + __builtin_amdgcn_exp2f(__builtin_fmaf(acc[ai][bj][0][n][e], c1, -7.f)));
                        v1[e] = __builtin_amdgcn_rcpf(c0 + __builtin_amdgcn_exp2f(__builtin_fmaf(acc[ai][bj][1][n][e], c1, -7.f)));
                        v2[e] = __builtin_amdgcn_rcpf(c0 + __builtin_amdgcn_exp2f(__builtin_fmaf(acc[ai][bj][2][n][e], c1, -7.f)));
                        v3[e] = __builtin_amdgcn_rcpf(c0 + __builtin_amdgcn_exp2f(__builtin_fmaf(acc[ai][bj][3][n][e], c1, -7.f)));
                    }
                }
                if (f8) {
                    if (kind != 3) { v0 *= qscale; v1 *= qscale; v2 *= qscale; v3 *= qscale; }
                    unsigned p0 = pack4f8(v0[0], v0[1], v0[2], v0[3]), p1 = pack4f8(v1[0], v1[1], v1[2], v1[3]), p2 = pack4f8(v2[0], v2[1], v2[2], v2[3]), p3 = pack4f8(v3[0], v3[1], v3[2], v3[3]);
                    TR4(p0, p1, p2, p3);
                    char* o = (char*)out + (size_t)((bj * 128 + n * 16) * ldo + ai * 128) + loff + fq * 12;
                    *(u32x4*)o = (u32x4){p0, p1, p2, p3};
                } else {
                    char* o = (char*)out + (size_t)(((bj * 128 + n * 16) * ldo + ai * 128) * 2) + loff + fq * 24;
                    const uint2 q0 = pack4(v0), q1 = pack4(v1), q2 = pack4(v2), q3 = pack4(v3);
                    ST16x2(o, q0, q1, q2, q3);
                }
            }
        }
    }
};
struct EpiV {
    unsigned char* vt;
    __device__ __forceinline__ void operator()(Acc& acc, int wr, int wc, int fr, int fq) {
        const unsigned loff = EPI_LOFF16(SK, 1);
#pragma unroll
        EPI_LOOP3 { const f32x4 v0 = acc[ai][bj][0][n] * (1.f / 32.f), v1 = acc[ai][bj][1][n] * (1.f / 32.f), v2 = acc[ai][bj][2][n] * (1.f / 32.f), v3 = acc[ai][bj][3][n] * (1.f / 32.f);
            unsigned p0 = pack4f8(v0[0], v0[1], v0[2], v0[3]), p1 = pack4f8(v1[0], v1[1], v1[2], v1[3]), p2 = pack4f8(v2[0], v2[1], v2[2], v2[3]), p3 = pack4f8(v3[0], v3[1], v3[2], v3[3]);
            TR4(p0, p1, p2, p3);
            *(u32x4*)((char*)vt + EPI_UOFF3(SK, 1) + loff) = (u32x4){p0, p1, p2, p3}; }
    }
};
struct EpiStoreF8 {
    unsigned char* out; float sc;
    __device__ __forceinline__ void operator()(Acc& acc, int wr, int wc, int fr, int fq) {
        const unsigned loff = EPI_LOFF16(2048, 1);
#pragma unroll
        EPI_LOOP3 { const f32x4 v0 = acc[ai][bj][0][n] * sc, v1 = acc[ai][bj][1][n] * sc, v2 = acc[ai][bj][2][n] * sc, v3 = acc[ai][bj][3][n] * sc;
            unsigned p0 = pack4f8(v0[0], v0[1], v0[2], v0[3]), p1 = pack4f8(v1[0], v1[1], v1[2], v1[3]), p2 = pack4f8(v2[0], v2[1], v2[2], v2[3]), p3 = pack4f8(v3[0], v3[1], v3[2], v3[3]);
            TR4(p0, p1, p2, p3);
            *(u32x4*)((char*)out + EPI_UOFF3(2048, 1) + loff) = (u32x4){p0, p1, p2, p3}; }
    }
};
struct EpiPool {
    unsigned char* out; const float* scale;
    __device__ __forceinline__ void operator()(Acc& acc, int wr, int wc, int fr, int fq) {
        const unsigned loff = EPI_LOFF(512, 1), iloff = EPI_ILOFF(4);
#pragma unroll
        EPI_LOOP3 { unsigned pk[4];
#pragma unroll
            for (int m = 0; m < 4; ++m) { const f32x4 s = *(const f32x4*)((const char*)scale + EPI_IUOFF(4) + iloff); const f32x4 v = acc[ai][bj][m][n] * s * 4.f; pk[m] = pack4f8(v[0], v[1], v[2], v[3]); }
            unsigned p0 = pk[0], p1 = pk[1], p2 = pk[2], p3 = pk[3];
            TR4(p0, p1, p2, p3);
            *(u32x4*)((char*)out + EPI_UOFF3(512, 1) + loff + fq * 12) = (u32x4){p0, p1, p2, p3}; }
    }
};
struct EpiS5E {
    float* out;
    __device__ __forceinline__ void operator()(Acc& acc, int wr, int wc, int fr, int fq) {
        const unsigned loff = EPI_LOFF(256, 4);
#pragma unroll
        EPI_LOOP { *(f32x4*)((char*)out + EPI_UOFF(256, 4) + loff) = acc[ai][bj][m][n]; }
    }
};
struct EpiS5Y {
    u16* yg; int g, it, nt;
    __device__ __forceinline__ void operator()(Acc& acc, int wr, int wc, int fr, int fq) {
        if (nt < 4) {
            const unsigned loff = (unsigned)(((((wc * 32 + fr) * S5L + wr * 4) * 512) + fq * 4) * 2);
#pragma unroll
            EPI_LOOP { f32x4 v = acc[ai][bj][m][n];
#pragma unroll
                for (int e = 0; e < 4; ++e) v[e] = gelu_tanh(v[e]);
                const size_t uo = ((size_t)((nt * 2 + bj) * SEQ + n * 16 * S5L + it * 16 + ai * 8 + m) * 512 + g * 16) * 2;
                *(uint2*)((char*)yg + uo + loff) = pack4(v); }
        } else {
            if (wc < 2) {
                const unsigned loff = (unsigned)(((((wc * 4 + (fr >> 3)) * CTXL + (fr & 7) * S5L + wr * 4) * 512) + fq * 4) * 2);
#pragma unroll
                for (int ai = 0; ai < 2; ++ai)
#pragma unroll
                for (int m = 0; m < 4; ++m)
#pragma unroll
                for (int n = 0; n < 2; ++n) { f32x4 v = acc[ai][0][m][n];
#pragma unroll
                    for (int e = 0; e < 4; ++e) v[e] = gelu_tanh(v[e]);
                    const size_t uo = ((size_t)(RL + n * 2 * CTXL + it * 16 + ai * 8 + m) * 512 + g * 16) * 2;
                    *(uint2*)((char*)yg + uo + loff) = pack4(v); }
            }
        }
    }
};
struct EpiGlu {
    unsigned char* out; const u16* yg;
    __device__ __forceinline__ void operator()(Acc& acc, int wr, int wc, int fr, int fq) {
        const unsigned loff = EPI_LOFF(512, 2), loff1 = EPI_LOFF(512, 1);
#pragma unroll
        EPI_LOOP3 { uint2 g4[4]; LD16x2((const char*)yg + EPI_UOFF3(512, 2) + loff + fq * 24, g4[0], g4[1], g4[2], g4[3]);
            unsigned pk[4];
#pragma unroll
            for (int m = 0; m < 4; ++m) { const f32x4 gg = unpack4(g4[m]); f32x4 v = acc[ai][bj][m][n];
#pragma unroll
                for (int e = 0; e < 4; ++e) v[e] = 4.f * gg[e] * sigmoidf_(v[e]);
                pk[m] = pack4f8(v[0], v[1], v[2], v[3]); }
            unsigned p0 = pk[0], p1 = pk[1], p2 = pk[2], p3 = pk[3];
            TR4(p0, p1, p2, p3);
            *(u32x4*)((char*)out + EPI_UOFF3(512, 1) + loff1 + fq * 12) = (u32x4){p0, p1, p2, p3}; }
    }
};
struct EpiMerge {
    unsigned char* mrg8; const unsigned char* gate; int br;
    __device__ __forceinline__ void operator()(Acc& acc, int wr, int wc, int fr, int fq) {
        const unsigned loffg = EPI_LOFF(6144, 1), loff8 = EPI_LOFF(2048, 1);
        const float GE = 0.0009765625f;
        const bool more = br < 2; const unsigned char* gnext = more ? gate + 2048 : gate;
#pragma unroll
        for (int ai = 0; ai < 2; ++ai) {
#pragma unroll
            for (int bj = 0; bj < 2; ++bj)
#pragma unroll
            for (int n = 0; n < 2; ++n) {
                const size_t uo = (size_t)((bj * 128 + n * 16) * 6144 + ai * 128);
                const u32x4 qa = *(const u32x4*)((const char*)gate + uo + loffg + fq * 12), qb = *(const u32x4*)((const char*)gnext + uo + loffg + fq * 12);
                unsigned a0 = qa[0], a1 = qa[1], a2 = qa[2], a3 = qa[3], b0 = qb[0], b1 = qb[1], b2 = qb[2], b3 = qb[3];
                TR4(a0, a1, a2, a3); TR4(b0, b1, b2, b3);
#pragma unroll
                for (int m = 0; m < 4; ++m) {
                    const int ga = (int)((m == 0) ? a0 : (m == 1) ? a1 : (m == 2) ? a2 : a3), gb = (int)((m == 0) ? b0 : (m == 1) ? b1 : (m == 2) ? b2 : b3);
                    const f32x2 a01 = __builtin_amdgcn_cvt_pk_f32_fp8(ga, false), a23 = __builtin_amdgcn_cvt_pk_f32_fp8(ga, true);
                    const f32x2 b01 = __builtin_amdgcn_cvt_pk_f32_fp8(gb, false), b23 = __builtin_amdgcn_cvt_pk_f32_fp8(gb, true);
                    const float r0 = more ? __builtin_amdgcn_rcpf(b01[0] + GE) : (4.f / (64.f * 128.f)), r1 = more ? __builtin_amdgcn_rcpf(b01[1] + GE) : (4.f / (64.f * 128.f));
                    const float r2 = more ? __builtin_amdgcn_rcpf(b23[0] + GE) : (4.f / (64.f * 128.f)), r3 = more ? __builtin_amdgcn_rcpf(b23[1] + GE) : (4.f / (64.f * 128.f));
                    acc[ai][bj][m][n] *= (f32x4){(a01[0] + GE) * r0, (a01[1] + GE) * r1, (a23[0] + GE) * r2, (a23[1] + GE) * r3}; }
            }
            __builtin_amdgcn_sched_barrier(0); }
        if (!more) {
#pragma unroll
            for (int ai = 0; ai < 2; ++ai)
#pragma unroll
            for (int bj = 0; bj < 2; ++bj)
#pragma unroll
            for (int n = 0; n < 2; ++n) {
                const f32x4 v0 = acc[ai][bj][0][n], v1 = acc[ai][bj][1][n], v2 = acc[ai][bj][2][n], v3 = acc[ai][bj][3][n];
                unsigned p0 = pack4f8(v0[0], v0[1], v0[2], v0[3]), p1 = pack4f8(v1[0], v1[1], v1[2], v1[3]), p2 = pack4f8(v2[0], v2[1], v2[2], v2[3]), p3 = pack4f8(v3[0], v3[1], v3[2], v3[3]);
                TR4(p0, p1, p2, p3);
                *(u32x4*)((char*)mrg8 + (size_t)((bj * 128 + n * 16) * 2048 + ai * 128) + loff8 + fq * 12) = (u32x4){p0, p1, p2, p3};
            }
        }
    }
};
struct EpiRes {
    const void* xin; void* xout; const float* gate; float sc; bool in16, out16;
    __device__ __forceinline__ void operator()(Acc& acc, int wr, int wc, int fr, int fq) {
        const unsigned loff4 = EPI_LOFF(2048, 4), loff2 = EPI_LOFF(2048, 2), iloff = EPI_ILOFF(4);
#pragma unroll
        EPI_LOOP3 { uint2 xi[4], yo[4];
            if (in16) LD16x2((const char*)xin + EPI_UOFF3(2048, 2) + loff2 + fq * 24, xi[0], xi[1], xi[2], xi[3]);
#pragma unroll
            for (int m = 0; m < 4; ++m) { const f32x4 gg = *(const f32x4*)((const char*)gate + EPI_IUOFF(4) + iloff);
                f32x4 x;
                if (in16) x = unpack4(xi[m]); else x = *(const f32x4*)((const char*)xin + EPI_UOFF(2048, 4) + loff4);
                const f32x4 y = x + gg * acc[ai][bj][m][n] * sc;
                if (out16) yo[m] = pack4(y); else *(f32x4*)((char*)xout + EPI_UOFF(2048, 4) + loff4) = y; }
            if (out16) ST16x2((char*)xout + EPI_UOFF3(2048, 2) + loff2 + fq * 24, yo[0], yo[1], yo[2], yo[3]); }
    }
};
struct EpiF16 {
    _Float16* out; float sc;
    __device__ __forceinline__ void operator()(Acc& acc, int wr, int wc, int fr, int fq) {
        const unsigned loff = EPI_LOFF(2048, 2);
#pragma unroll
        EPI_LOOP3 { uint2 pk[4];
#pragma unroll
            for (int m = 0; m < 4; ++m) { const f32x4 v = acc[ai][bj][m][n] * sc; const h16x2 lo = (h16x2){(_Float16)v[0], (_Float16)v[1]}, hi = (h16x2){(_Float16)v[2], (_Float16)v[3]};
                pk[m].x = __builtin_bit_cast(unsigned, lo); pk[m].y = __builtin_bit_cast(unsigned, hi); }
            ST16x2((char*)out + EPI_UOFF3(2048, 2) + loff + fq * 24, pk[0], pk[1], pk[2], pk[3]); }
    }
};

__device__ __forceinline__ void transpose_item(const float* src, long lds_, u16* dst, long ldd, int k0, int n0, u16* scr, int lane) {
#pragma unroll 4
    for (int it = 0; it < 16; ++it) {
        const int r = it * 4 + (lane >> 4), c = (lane & 15) * 4;
        const float4 v = *(const float4*)(src + (long)(k0 + r) * lds_ + n0 + c);
        scr[(c + 0) * 72 + r] = (u16)(cvtpk(v.x, 0.f) & 0xffff); scr[(c + 1) * 72 + r] = (u16)(cvtpk(v.y, 0.f) & 0xffff);
        scr[(c + 2) * 72 + r] = (u16)(cvtpk(v.z, 0.f) & 0xffff); scr[(c + 3) * 72 + r] = (u16)(cvtpk(v.w, 0.f) & 0xffff);
    }
    __builtin_amdgcn_s_waitcnt(0xc07f);
    __builtin_amdgcn_wave_barrier();
#pragma unroll 4
    for (int it = 0; it < 8; ++it) {
        const int id = it * 64 + lane, nn = id >> 3, ch = id & 7;
        const uint4 v = *(const uint4*)(scr + nn * 72 + ch * 8);
        *(uint4*)(dst + (long)(n0 + nn) * ldd + k0 + ch * 8) = v;
    }
    __builtin_amdgcn_s_waitcnt(0xc07f);
    __builtin_amdgcn_wave_barrier();
}

__device__ __forceinline__ void transpose_item4(const float* src, long lds_, unsigned char* dst4, long ldd, int k0, int n0, unsigned char* scr, int lane, float scale) {
#pragma unroll 4
    for (int it = 0; it < 8; ++it) {
        const int r2 = it * 4 + (lane >> 4), c = (lane & 15) * 4;
        const float4 v0 = *(const float4*)(src + (long)(k0 + 2 * r2) * lds_ + n0 + c), v1 = *(const float4*)(src + (long)(k0 + 2 * r2 + 1) * lds_ + n0 + c);
        unsigned b = 0u;
        b = __builtin_amdgcn_cvt_scalef32_pk_fp4_f32(b, v0.x * scale, v1.x * scale, 1.0f, 0); b = __builtin_amdgcn_cvt_scalef32_pk_fp4_f32(b, v0.y * scale, v1.y * scale, 1.0f, 1);
        b = __builtin_amdgcn_cvt_scalef32_pk_fp4_f32(b, v0.z * scale, v1.z * scale, 1.0f, 2); b = __builtin_amdgcn_cvt_scalef32_pk_fp4_f32(b, v0.w * scale, v1.w * scale, 1.0f, 3);
        scr[(c + 0) * 48 + r2] = (unsigned char)(b & 0xff); scr[(c + 1) * 48 + r2] = (unsigned char)((b >> 8) & 0xff);
        scr[(c + 2) * 48 + r2] = (unsigned char)((b >> 16) & 0xff); scr[(c + 3) * 48 + r2] = (unsigned char)(b >> 24);
    }
    __builtin_amdgcn_s_waitcnt(0xc07f);
    __builtin_amdgcn_wave_barrier();
#pragma unroll
    for (int it = 0; it < 2; ++it) {
        const int id = it * 64 + lane, nn = id >> 1, ch = id & 1;
        const uint4 v = *(const uint4*)(scr + nn * 48 + ch * 16);
        *(uint4*)(dst4 + (long)(n0 + nn) * ldd + k0 / 2 + ch * 16) = v;
    }
    __builtin_amdgcn_s_waitcnt(0xc07f);
    __builtin_amdgcn_wave_barrier();
}
__device__ __forceinline__ void transpose_item8(const float* src, long lds_, unsigned char* dst, long ldd, int k0, int n0, unsigned char* scr, int lane, float scale) {
#pragma unroll 4
    for (int it = 0; it < 16; ++it) {
        const int r = it * 4 + (lane >> 4), c = (lane & 15) * 4;
        const float4 v = *(const float4*)(src + (long)(k0 + r) * lds_ + n0 + c);
        const unsigned pk = pack4f8(v.x * scale, v.y * scale, v.z * scale, v.w * scale);
        scr[(c + 0) * 80 + r] = (unsigned char)(pk & 0xff); scr[(c + 1) * 80 + r] = (unsigned char)((pk >> 8) & 0xff);
        scr[(c + 2) * 80 + r] = (unsigned char)((pk >> 16) & 0xff); scr[(c + 3) * 80 + r] = (unsigned char)(pk >> 24);
    }
    __builtin_amdgcn_s_waitcnt(0xc07f);
    __builtin_amdgcn_wave_barrier();
#pragma unroll
    for (int it = 0; it < 4; ++it) {
        const int id = it * 64 + lane, nn = id >> 2, ch = id & 3;
        const uint4 v = *(const uint4*)(scr + nn * 80 + ch * 16);
        *(uint4*)(dst + (long)(n0 + nn) * ldd + k0 + ch * 16) = v;
    }
    __builtin_amdgcn_s_waitcnt(0xc07f);
    __builtin_amdgcn_wave_barrier();
}

template <bool F8, bool IN16 = false>
__device__ __forceinline__ void rms_mod_row(const void* xr, const float* g, const float* shift, const float* scale, void* o, int lane, unsigned* o4 = nullptr, unsigned char* o8 = nullptr) {
    float4 v[8]; float ss = 0.f;
#pragma unroll
    for (int i = 0; i < 4; ++i) {
        if (IN16) { const u32x4 t = ((const u32x4*)xr)[lane + 64 * i]; const unsigned t0 = t[0], t1 = t[1], t2 = t[2], t3 = t[3];
            v[2 * i] = make_float4(bflo(t0), bfhi(t0), bflo(t1), bfhi(t1)); v[2 * i + 1] = make_float4(bflo(t2), bfhi(t2), bflo(t3), bfhi(t3)); }
        else { v[2 * i] = ((const float4*)xr)[(lane + 64 * i) * 2]; v[2 * i + 1] = ((const float4*)xr)[(lane + 64 * i) * 2 + 1]; }
    }
#pragma unroll
    for (int i = 0; i < 8; ++i) ss += v[i].x * v[i].x + v[i].y * v[i].y + v[i].z * v[i].z + v[i].w * v[i].w;
#pragma unroll
    for (int of = 32; of > 0; of >>= 1) ss += __shfl_xor(ss, of);
    const float inv = rsqrtf(ss * (1.f / 2048.f) + 1e-6f);
#pragma unroll
    for (int i = 0; i < 4; ++i) {
        unsigned pk[4], p8[2] = {0u, 0u};
#pragma unroll
        for (int h = 0; h < 2; ++h) {
            const int vi = (lane + 64 * i) * 2 + h;
            const float4 gg = ((const float4*)g)[vi], sh = ((const float4*)shift)[vi], sc = ((const float4*)scale)[vi]; const float4 x = v[2 * i + h];
            const float y0 = x.x * inv * gg.x * (1.f + sc.x) + sh.x, y1 = x.y * inv * gg.y * (1.f + sc.y) + sh.y;
            const float y2 = x.z * inv * gg.z * (1.f + sc.z) + sh.z, y3 = x.w * inv * gg.w * (1.f + sc.w) + sh.w;
            if (F8) { pk[h] = pack4f8(y0, y1, y2, y3);
                if (h == 0) { pk[2] = __builtin_amdgcn_cvt_scalef32_pk_fp4_f32(0u, y0 * G4_HS, y1 * G4_HS, 1.0f, 0); pk[2] = __builtin_amdgcn_cvt_scalef32_pk_fp4_f32(pk[2], y2 * G4_HS, y3 * G4_HS, 1.0f, 1); }
                else { pk[2] = __builtin_amdgcn_cvt_scalef32_pk_fp4_f32(pk[2], y0 * G4_HS, y1 * G4_HS, 1.0f, 2); pk[2] = __builtin_amdgcn_cvt_scalef32_pk_fp4_f32(pk[2], y2 * G4_HS, y3 * G4_HS, 1.0f, 3); } }
            else { pk[2 * h] = cvtpk(y0, y1); pk[2 * h + 1] = cvtpk(y2, y3); if (o8) p8[h] = pack4f8(y0, y1, y2, y3); }
        }
        if (!F8 && o8) { uint2 q2; q2.x = p8[0]; q2.y = p8[1]; ((uint2*)o8)[lane + 64 * i] = q2; }
        if (F8 && o4) o4[lane + 64 * i] = pk[2];
        if (F8) { uint2 p2; p2.x = pk[0]; p2.y = pk[1]; ((uint2*)o)[lane + 64 * i] = p2; }
        else ((u32x4*)o)[lane + 64 * i] = (u32x4){pk[0], pk[1], pk[2], pk[3]};
    }
}

__device__ __forceinline__ void s5_lampow(float ar, float ai, float dt, float n, float& re, float& im) {
    const float mag = expf(ar * dt * n); float s, c; sincosf(ai * dt * n, &s, &c); re = mag * c; im = mag * s;
}
__device__ __forceinline__ void s5_coef(float ar, float ai, float dt, float& cre, float& cim) {
    float lr, li; s5_lampow(ar, ai, dt, 1.f, lr, li);
    const float den = ar * ar + ai * ai;
    cre = ((lr - 1.f) * ar + li * ai) / den; cim = (li * ar - (lr - 1.f) * ai) / den;
}

constexpr int AROW = 144, AKBUF = 128 * AROW, AVBUF = 144 * AROW;
__device__ __forceinline__ void attn_prep(char* shm) {
    const int tid = otid();
    for (int i = tid; i < 2 * 16 * 36; i += 512) { const int bufi = i / 576, r = (i % 576) / 36, c = i % 36;
        *(unsigned*)(shm + 2 * AKBUF + bufi * AVBUF + (128 + r) * AROW + c * 4) = (r == 0) ? 0x38383838u : 0u; }
    __syncthreads();
}
__device__ __forceinline__ void attn_unit(const unsigned char* __restrict__ Q8, const unsigned char* __restrict__ K8, const unsigned char* __restrict__ Vt8, unsigned char* __restrict__ Yatt,
                                          int b, int hd, int qrow0, int kt_lo, int kt_hi, float lam, float post_scale, const float* __restrict__ subg, char* shm) {
    const int tid = otid(), wave = tid >> 6, lane = tid & 63, q = lane & 15, g4 = lane >> 4;
    char* kbuf = shm; char* vbuf = shm + 2 * AKBUF;
    const unsigned char* qp = Q8 + (long)(qrow0 + wave * 16 + q) * 1024 + hd * 128;
    long qf[2][2];
#pragma unroll
    for (int c = 0; c < 2; ++c)
#pragma unroll
        for (int ks = 0; ks < 2; ++ks) qf[c][ks] = *(const long*)(qp + c * 64 + ks * 32 + g4 * 8);
    f32x4 O[2][8], OL[2];
#pragma unroll
    for (int c = 0; c < 2; ++c) { OL[c] = (f32x4){0.f, 0.f, 0.f, 0.f};
#pragma unroll
        for (int db = 0; db < 8; ++db) O[c][db] = (f32x4){0.f, 0.f, 0.f, 0.f}; }
    float mrun0 = 0.f, mrun1 = 0.f;
    const unsigned char* vtb = Vt8 + ((long)(b * 8 + hd) * 128) * SK;
    const int sr0 = tid >> 3, sc0 = tid & 7;
    const int kp0 = 16 * ((sr0 >> 2) & 7) + 4 * (sr0 >> 5) + (sr0 & 3);
    const int vsw0 = sc0 ^ (2 * (((sr0 >> 2) ^ (sr0 >> 3)) & 1));
    u32x4 kreg0, kreg1, vreg0, vreg1;
#define ATT_LOAD(kt) do { const long krow = ((kt) < 32) ? ((long)b * SEQ + (kt) * 128) : ((long)RL + b * CTXL + ((kt) - 32) * 128); \
        kreg0 = *(const u32x4*)(K8 + (krow + sr0) * 1024 + hd * 128 + sc0 * 16); kreg1 = *(const u32x4*)(K8 + (krow + sr0 + 64) * 1024 + hd * 128 + sc0 * 16); \
        vreg0 = *(const u32x4*)(vtb + (long)sr0 * SK + (kt) * 128 + sc0 * 16); vreg1 = *(const u32x4*)(vtb + (long)(sr0 + 64) * SK + (kt) * 128 + sc0 * 16); } while (0)
#define ATT_STORE(bufi) do { *(u32x4*)(kbuf + (bufi) * AKBUF + kp0 * AROW + sc0 * 16) = kreg0; *(u32x4*)(kbuf + (bufi) * AKBUF + (kp0 + 8) * AROW + sc0 * 16) = kreg1; \
        *(u32x4*)(vbuf + (bufi) * AVBUF + sr0 * AROW + vsw0 * 16) = vreg0; *(u32x4*)(vbuf + (bufi) * AVBUF + (sr0 + 64) * AROW + vsw0 * 16) = vreg1; } while (0)
    ATT_LOAD(kt_lo); ATT_STORE(0);
    __syncthreads();
    int cur = 0;
    for (int kt = kt_lo; kt < kt_hi; ++kt) {
        const bool more = (kt + 1 < kt_hi), first = (kt == kt_lo);
        if (more) ATT_LOAD(kt + 1);
        __builtin_amdgcn_sched_barrier(0);
        const char* Kc = kbuf + cur * AKBUF; const char* Vc = vbuf + cur * AVBUF;
        v8i pf[2];
#pragma unroll
        for (int c = 0; c < 2; ++c) {
            float mr = c ? mrun1 : mrun0;
            f32x4 st[8];
#pragma unroll
            for (int mb = 0; mb < 8; ++mb) st[mb] = (f32x4){-mr, -mr, -mr, -mr};
            __builtin_amdgcn_s_setprio(1);
#pragma unroll
            for (int ks = 0; ks < 2; ++ks)
#pragma unroll
                for (int mb = 0; mb < 8; ++mb) {
                    const long kf = *(const long*)(Kc + (16 * mb + q) * AROW + c * 64 + ks * 32 + g4 * 8);
                    st[mb] = __builtin_amdgcn_mfma_f32_16x16x32_fp8_fp8(kf, qf[c][ks], st[mb], 0, 0, 0);
                }
            __builtin_amdgcn_s_setprio(0);
            float tmax, tm2;
            asm volatile("s_nop 7\n\ts_nop 7" : "+v"(st[0]), "+v"(st[1]), "+v"(st[2]), "+v"(st[3]), "+v"(st[4]), "+v"(st[5]), "+v"(st[6]), "+v"(st[7]));
            asm("v_max3_f32 %0, %1, %2, %3" : "=v"(tmax) : "v"(st[0][0]), "v"(st[0][1]), "v"(st[0][2]));
            asm("v_max3_f32 %0, %1, %2, %3" : "=v"(tm2) : "v"(st[0][3]), "v"(st[1][0]), "v"(st[1][1]));
#pragma unroll
            for (int mb = 1; mb < 8; ++mb) {
                if (mb > 1) { asm("v_max3_f32 %0, %1, %2, %3" : "+v"(tmax) : "v"(st[mb][0]), "v"(st[mb][1]), "v"(tmax)); }
                asm("v_max3_f32 %0, %1, %2, %3" : "+v"(tm2) : "v"(st[mb][2]), "v"(st[mb][3]), "v"(tm2));
            }
            asm("v_max3_f32 %0, %1, %2, %3" : "+v"(tmax) : "v"(st[1][0]), "v"(st[1][1]), "v"(tmax));
            asm("v_max3_f32 %0, %1, %2, %3" : "+v"(tmax) : "v"(tm2), "v"(tm2), "v"(tmax));
            { const auto r16 = __builtin_amdgcn_permlane16_swap(__float_as_uint(tmax), __float_as_uint(tmax), false, false); tmax = fmaxf(__uint_as_float(r16[0]), __uint_as_float(r16[1])); }
            { const auto r32 = __builtin_amdgcn_permlane32_swap(__float_as_uint(tmax), __float_as_uint(tmax), false, false); tmax = fmaxf(__uint_as_float(r32[0]), __uint_as_float(r32[1])); }
            if (first || __any(tmax > 8.f)) {
                asm volatile("" ::: "memory");
                const float delta = (first || tmax > 8.f) ? tmax - 6.f : 0.f;
                const float alpha = __builtin_amdgcn_exp2f(-delta);
                mr += delta;
#pragma unroll
                for (int mb = 0; mb < 8; ++mb) st[mb] -= delta;
#pragma unroll
                for (int db = 0; db < 8; ++db) O[c][db] *= alpha;
                OL[c] *= alpha;
            }
            if (c) mrun1 = mr; else mrun0 = mr;
            v8i pk;
#pragma unroll
            for (int mb = 0; mb < 8; ++mb)
                pk[mb] = (int)pack4f8(__builtin_amdgcn_exp2f(st[mb][0]), __builtin_amdgcn_exp2f(st[mb][1]), __builtin_amdgcn_exp2f(st[mb][2]), __builtin_amdgcn_exp2f(st[mb][3]));
            pf[c] = pk;
        }
        asm volatile("s_nop 1" : "+v"(pf[0]), "+v"(pf[1]));
        __builtin_amdgcn_s_setprio(1);
        {
            const int vsx = (g4 ^ (((q >> 2) ^ (q >> 3)) & 1)) * 32;
            const char* vr0 = Vc + q * AROW + vsx;
            v8i vfa = __builtin_shufflevector(*(const v4i*)(vr0), *(const v4i*)(vr0 + 16), 0, 1, 2, 3, 4, 5, 6, 7), vfb;
#pragma unroll
            for (int db = 0; db < 9; ++db) {
                if (db < 8) { const char* vr = Vc + ((db + 1) * 16 + q) * AROW + vsx;
                    vfb = __builtin_shufflevector(*(const v4i*)(vr), *(const v4i*)(vr + 16), 0, 1, 2, 3, 4, 5, 6, 7); }
                if (db < 8) {
                    asm("v_mfma_f32_16x16x128_f8f6f4 %0, %1, %2, %0" : "+v"(O[0][db]) : "v"(vfa), "v"(pf[0]));
                    asm("v_mfma_f32_16x16x128_f8f6f4 %0, %1, %2, %0" : "+v"(O[1][db]) : "v"(vfa), "v"(pf[1]));
                } else {
                    asm("v_mfma_f32_16x16x128_f8f6f4 %0, %1, %2, %0" : "+v"(OL[0]) : "v"(vfa), "v"(pf[0]));
                    asm("v_mfma_f32_16x16x128_f8f6f4 %0, %1, %2, %0" : "+v"(OL[1]) : "v"(vfa), "v"(pf[1]));
                }
                vfa = vfb;
            }
        }
        __builtin_amdgcn_s_setprio(0);
        if (more) ATT_STORE(cur ^ 1);
        __syncthreads();
        cur ^= 1;
    }
#undef ATT_LOAD
#undef ATT_STORE
    asm volatile("s_nop 7\n\ts_nop 7\n\ts_nop 7" : "+v"(O[0][0]), "+v"(O[0][1]), "+v"(O[0][2]), "+v"(O[0][3]), "+v"(O[0][4]), "+v"(O[0][5]), "+v"(O[0][6]), "+v"(O[0][7]),
                 "+v"(O[1][0]), "+v"(O[1][1]), "+v"(O[1][2]), "+v"(O[1][3]), "+v"(O[1][4]), "+v"(O[1][5]), "+v"(O[1][6]), "+v"(O[1][7]), "+v"(OL[0]), "+v"(OL[1]));
    const float l0 = __shfl(OL[0][0], q), l1 = __shfl(OL[1][0], q);
    const float i0 = 1.f / l0, i1 = lam / l1;
    float ss = 0.f;
#pragma unroll
    for (int db = 0; db < 8; ++db)
#pragma unroll
        for (int e = 0; e < 4; ++e) { const float o = O[0][db][e] * i0 - O[1][db][e] * i1; O[0][db][e] = o; ss += o * o; }
    ss += __shfl_xor(ss, 16); ss += __shfl_xor(ss, 32);
    const float rs = rsqrtf(ss * (1.f / 128.f) + 1e-6f) * post_scale * 4.f;
    unsigned char* yo = Yatt + (long)(qrow0 + wave * 16 + q) * 1024 + hd * 128;
#pragma unroll
    for (int db = 0; db < 8; ++db) {
        const int dv = db * 16 + g4 * 4; const f32x4 gg = *(const f32x4*)(subg + dv);
        const f32x4 ov = O[0][db] * gg * rs; *(unsigned*)(yo + dv) = pack4f8(ov[0], ov[1], ov[2], ov[3]);
    }
}

__device__ __forceinline__ unsigned fenc(float f) { const unsigned u = __float_as_uint(f); return u ^ ((unsigned)((int)u >> 31) | 0x80000000u); }
__device__ __forceinline__ float fdec(unsigned k) { return __uint_as_float(k ^ (~(unsigned)((int)k >> 31) | 0x80000000u)); }
#define INS32(L, x) do { unsigned _x = (x); _Pragma("unroll") for (int _i = 0; _i < 16; ++_i) { const unsigned _h = max(L[_i], _x); _x = min(L[_i], _x); L[_i] = _h; } } while (0)
#define INS64(L, x) do { unsigned long long _x = (x); _Pragma("unroll") for (int _i = 0; _i < 16; ++_i) { const unsigned long long _a = L[_i]; const bool _g = _a > _x; L[_i] = _g ? _a : _x; _x = _g ? _x : _a; } } while (0)
#define CSWAP_D(a, b) do { const unsigned _h = max(a, b), _l = min(a, b); a = _h; b = _l; } while (0)
__device__ __forceinline__ void sort16_desc(unsigned (&v)[16]) {
#pragma unroll
    for (int k = 2; k <= 16; k <<= 1)
#pragma unroll
        for (int j = k >> 1; j > 0; j >>= 1)
#pragma unroll
            for (int i = 0; i < 16; ++i) { const int l = i ^ j; if (l > i) { if ((i & k) == 0) CSWAP_D(v[i], v[l]); else CSWAP_D(v[l], v[i]); } }
}
__device__ __forceinline__ void merge16_desc(unsigned (&L)[16], const unsigned (&B)[16]) {
#pragma unroll
    for (int i = 0; i < 16; ++i) L[i] = max(L[i], B[15 - i]);
#pragma unroll
    for (int j = 8; j > 0; j >>= 1)
#pragma unroll
        for (int i = 0; i < 16; ++i) if ((i & j) == 0) CSWAP_D(L[i], L[i + j]);
}

__device__ __forceinline__ void peer_tables_fp4(const float4* us, const float4* vs, unsigned char* U8, unsigned char* V8, long ibeg, long iend, long t, long nt) {
    for (long i = ibeg + t; i < iend; i += nt) {
        u32x4 pu, pv;
#pragma unroll
        for (int dd = 0; dd < 4; ++dd) {
            const float4 a0 = us[i * 8 + dd * 2], a1 = us[i * 8 + dd * 2 + 1], c0 = vs[i * 8 + dd * 2], c1 = vs[i * 8 + dd * 2 + 1];
            unsigned x = 0u, y = 0u;
            x = __builtin_amdgcn_cvt_scalef32_pk_fp4_f32(x, a0.x * PEER_USC, a0.y * PEER_USC, 1.0f, 0); x = __builtin_amdgcn_cvt_scalef32_pk_fp4_f32(x, a0.z * PEER_USC, a0.w * PEER_USC, 1.0f, 1);
            x = __builtin_amdgcn_cvt_scalef32_pk_fp4_f32(x, a1.x * PEER_USC, a1.y * PEER_USC, 1.0f, 2); x = __builtin_amdgcn_cvt_scalef32_pk_fp4_f32(x, a1.z * PEER_USC, a1.w * PEER_USC, 1.0f, 3);
            y = __builtin_amdgcn_cvt_scalef32_pk_fp4_f32(y, c0.x * PEER_VSC, c0.y * PEER_VSC, 1.0f, 0); y = __builtin_amdgcn_cvt_scalef32_pk_fp4_f32(y, c0.z * PEER_VSC, c0.w * PEER_VSC, 1.0f, 1);
            y = __builtin_amdgcn_cvt_scalef32_pk_fp4_f32(y, c1.x * PEER_VSC, c1.y * PEER_VSC, 1.0f, 2); y = __builtin_amdgcn_cvt_scalef32_pk_fp4_f32(y, c1.z * PEER_VSC, c1.w * PEER_VSC, 1.0f, 3);
            pu[dd] = x; pv[dd] = y;
        }
        ((u32x4*)U8)[i] = pu; ((u32x4*)V8)[i] = pv;
    }
}

__global__ void __launch_bounds__(512, 2) fwd_kernel(Params p) {
    extern __shared__ __attribute__((aligned(16))) unsigned char lds[];
    const int G = gridDim.x, bx = blockIdx.x;
    const int vb = (G % 8 == 0) ? (bx % 8) * (G / 8) + bx / 8 : bx;
    const int lo = p.ph_lo, hi = p.ph_hi;
    unsigned char* ws = p.ws;
    XcdBarrier bar; bar.bar = (unsigned*)(ws + WS_CTL); bar.x = 0; bar.st = nullptr;
    if (hi - lo > 1) {
        if (threadIdx.x == 0) *(uint4*)(lds + BAR_LDS_OFF) = make_uint4(0u, 0u, 0u, 0u);
        __syncthreads();
        bar = xcd_barrier_post((unsigned*)(ws + WS_CTL), (volatile LAS unsigned*)(lds + BAR_LDS_OFF));
    }
#define PH_IN(k) (lo <= (k) && (k) < hi)
#define PH_SEAM(k) do { if ((k) + 1 < hi) xcd_barrier(bar); } while (0)
    u16* shm16 = (u16*)lds;
    float* MODS = (float*)(ws + WS_MODS);
    float2* ROPE = (float2*)(ws + WS_ROPE);
    float* XC = (float*)(ws + WS_XC);
    u16* XB = (u16*)(ws + WS_XB);
    u16* Hb = (u16*)(ws + WS_H);
    u16* PD = (u16*)(ws + WS_PD); u16* UT = (u16*)(ws + WS_UT); u16* YG = (u16*)(ws + WS_YG);
    u16* POOLP = (u16*)(ws + WS_POOLP); u16* S5U = (u16*)(ws + WS_S5U); unsigned char* Q8 = ws + WS_Q; unsigned char* K8 = ws + WS_K;
    unsigned char* VT8 = ws + WS_VT; u16* GATE = (u16*)(ws + WS_GATE);
    unsigned char* YPOOL = ws + WS_YPOOL; unsigned char* YS5 = YPOOL + (size_t)R * 512; unsigned char* YATT = YPOOL + (size_t)R * 1024;
    unsigned char* MERGED8 = YPOOL + (size_t)R * 2048;
    u16* AC = (u16*)(ws + WS_AC); u16* AE = (u16*)(ws + WS_AE);
    float* EB = (float*)(ws + WS_E); _Float16* SCORES = (_Float16*)(ws + WS_SCORES);
    int* EL = (int*)(ws + WS_EL); float* GL = (float*)(ws + WS_GL);
    unsigned char* U8 = ws + WS_U16; unsigned char* V8 = ws + WS_V16;

    if (PH_IN(0)) {
        PH_TID
        u16* scr = (u16*)(lds + wave * 9216);
        const int gw = vb * 8 + wave, NGW = G * 8;
        constexpr int I_WIN = 32 * 160, I_BP = 8 * 32, I_BS = 8 * 32, I_BA = 16 * 32, I_WO = 32 * 32, I_GLU = 8 * 8, I_L = I_WIN + I_BP + I_BS + I_BA + I_WO + I_GLU;
        for (int it = gw; it < 2 * I_L; it += NGW) {
            const int l = it / I_L; int r = it % I_L;
            if (r < I_WIN) {
                if (!GATES_FP4 || r % 160 < 64) transpose_item8(pin(8) + (size_t)l * D * NIN, NIN, ws + WS_WIN + (size_t)l * NIN * D, D, (r / 160) * 64, (r % 160) * 64, (unsigned char*)scr, lane, 32.f);
                else transpose_item4(pin(8) + (size_t)l * D * NIN + 4096, NIN, ws + WS_W4 + (size_t)l * 6144 * 1024, 1024, (r / 160) * 64, (r % 160 - 64) * 64, (unsigned char*)scr, lane, G4_WS);
                continue; } r -= I_WIN;
            if (r < I_BP) { transpose_item8(pin(25) + (size_t)l * 512 * D, D, ws + WS_WBR + (size_t)l * D * D, D, (r / 32) * 64, (r % 32) * 64, (unsigned char*)scr, lane, 16.f); continue; } r -= I_BP;
            if (r < I_BS) { transpose_item8(pin(26) + (size_t)l * 512 * D, D, ws + WS_WBR + (size_t)l * D * D + 512, D, (r / 32) * 64, (r % 32) * 64, (unsigned char*)scr, lane, 16.f); continue; } r -= I_BS;
            if (r < I_BA) { transpose_item8(pin(27) + (size_t)l * 1024 * D, D, ws + WS_WBR + (size_t)l * D * D + 1024, D, (r / 32) * 64, (r % 32) * 64, (unsigned char*)scr, lane, 16.f); continue; } r -= I_BA;
            if (r < I_WO) { transpose_item8(pin(28) + (size_t)l * D * D, D, ws + WS_WOUT + (size_t)l * D * D, D, (r / 32) * 64, (r % 32) * 64, (unsigned char*)scr, lane, 32.f); continue; } r -= I_WO;
            transpose_item(pin(19) + (size_t)l * 512 * 512, 512, (u16*)(ws + WS_WGLU) + (size_t)l * 512 * 512, 512, (r / 8) * 64, (r % 8) * 64, scr, lane);
        }
        const long gt = (long)vb * 512 + tid, NGT = (long)G * 512;
        for (long i = gt; i < 2l * D * D / 4; i += NGT) {
            const float4 v = ((const float4*)pin(29))[i]; uint2 pk; pk.x = cvtpk(v.x, v.y); pk.y = cvtpk(v.z, v.w); ((uint2*)(ws + WS_WQ16))[i] = pk;
        }
        for (long i = gt; i < 2l * 8 * 256 * 256 / 4; i += NGT) {
            const long e = i * 4; const int cd = e & 255, ck = (e >> 8) & 255, hh = (e >> 16) & 7, l = e >> 19;
            const int c = ck >> 7, key = ck & 127, c2 = cd >> 7, d = cd & 127;
            uint2 pk = make_uint2(0u, 0u);
            if (c == c2) { const float4 v = *(const float4*)(pin(30) + ((((size_t)l * 8 + hh) * 2 + c) * 128 + key) * 128 + d); pk.x = cvtpk(v.x, v.y); pk.y = cvtpk(v.z, v.w); }
            ((uint2*)(ws + WS_KPAD))[i] = pk;
        }
        for (long i = gt; i < 2l * 512 * 512; i += NGT) {
            const int k = i & 511, n = (i >> 9) & 511, l = i >> 18;
            float v = 0.f;
            if ((k >> 7) == (n >> 7)) v = pin(9)[(((size_t)l * 4 + (n >> 7)) * 128 + (k & 127)) * 128 + (n & 127)];
            ((u16*)(ws + WS_WPOOL))[i] = (u16)(cvtpk(v, 0.f) & 0xffff);
        }
        for (long i = gt; i < 64 * 16; i += NGT) {
            const int pos = i >> 4, f = i & 15; const float fr = powf(10000.f, -(float)f / 16.f); const float a = (float)pos * fr; float s, c; sincosf(a, &s, &c);
            ROPE[i] = make_float2(c, s);
        }
        {
            float* sil = (float*)(lds + 18432);
            float* red = (float*)lds;
            __syncthreads();
            for (int i = tid; i < 9 * 2048; i += 512) { const int bb = i >> 11, k = i & 2047; const float cv = (bb < 8) ? pin(1)[bb * 2048 + k] : pin(3)[k]; sil[i] = cv * __builtin_amdgcn_rcpf(1.f + __builtin_amdgcn_exp2f(-1.4426950408889634f * cv)); }
            __syncthreads();
            for (int it = vb; it < 2 * 192; it += G) {
                const int l = it / 192, n0 = (it % 192) * 64;
                const float* w = pin(4) + (size_t)l * D * 12288 + n0 + lane;
                float a[9];
#pragma unroll
                for (int bb = 0; bb < 9; ++bb) a[bb] = 0.f;
                const int k0 = wave * 256;
#pragma unroll 32
                for (int k = 0; k < 256; ++k) {
                    const float wv = w[(size_t)(k0 + k) * 12288];
#pragma unroll
                    for (int bb = 0; bb < 9; ++bb) a[bb] += sil[bb * 2048 + k0 + k] * wv;
                }
#pragma unroll
                for (int bb = 0; bb < 9; ++bb) red[(wave * 9 + bb) * 64 + lane] = a[bb];
                __syncthreads();
                for (int i = tid; i < 9 * 64; i += 512) {
                    float s = 0.f;
#pragma unroll
                    for (int wv = 0; wv < 8; ++wv) s += red[wv * 576 + i];
                    const int bb = i >> 6, nn = i & 63;
                    MODS[((size_t)l * 9 + bb) * 12288 + n0 + nn] = s + pin(5)[(size_t)l * 12288 + n0 + nn];
                }
                __syncthreads();
            }
        }
        PH_SEAM(0);
    }

    for (int l = 0; l < 2; ++l) {
        const int P0 = 1 + l * NPL;
        const float* xl_in = pin(0);
        const float* xc_in = (l == 0) ? pin(2) : XC;
        const float* mods = MODS + (size_t)l * 9 * 12288;
        const int Ract = (l == 0) ? R : RL;
        const float lam_init = (l == 0) ? 0.2f : (0.8f - 0.6f * 0.7408182206817179f);
        const unsigned char* WIN8 = ws + WS_WIN + (size_t)l * NIN * D;
        const unsigned char* WBR8 = ws + WS_WBR + (size_t)l * D * D;
        const unsigned char* WOUT8 = ws + WS_WOUT + (size_t)l * D * D;
        const unsigned char* WPK8 = ws + WS_WPK + (size_t)l * D * D;

        if (l == 0 && PH_IN(P0 + 0)) {
            PH_TID
            for (int t = vb; t < 128; t += G) {
                const int l2 = t >> 6, kt = t & 7, hh = (t >> 3) & 7;
                EpiStoreF8 e{ws + WS_WPK + (size_t)l2 * D * D + (size_t)(hh * 256) * D + kt * 256, 32.f};
                gemm_tile<false>((const u16*)(ws + WS_WQ16) + (size_t)l2 * D * D + (size_t)(kt * 256) * D + hh * 256, D,
                          (const u16*)(ws + WS_KPAD) + ((size_t)l2 * 8 + hh) * 65536, 256, 256, shm16, e);
            }
            for (int r = vb * 8 + wave; r < R; r += G * 8) {
                const int bb = (r < RL) ? (r >> 12) : 8;
                const float* xr = (r < RL) ? xl_in + (size_t)r * D : xc_in + (size_t)(r - RL) * D;
                rms_mod_row<true>(xr, pin(6) + l * D, mods + bb * 12288, mods + bb * 12288 + D, (unsigned char*)Hb + (size_t)r * D, lane, GATES_FP4 ? (unsigned*)(ws + WS_H4 + (size_t)r * 1024) : nullptr);
            }
            PH_SEAM(P0 + 0);
        }

        if (PH_IN(P0 + 1)) {
            PH_TID
            constexpr int NTI = NIN / 256, NTJ = R / 256, GM = 8;
            for (int t = vb; t < NTI * NTJ; t += G) {
                const int grp = t / (GM * NTI), rem = t % (GM * NTI), rt = grp * GM + rem % GM, ct = rem / GM;
                const int f0 = ct * 256;
                if (l == 1 && rt >= 128 && !(f0 >= 512 && f0 < 1024) && !(f0 >= 2048 && f0 < 4096)) continue;
                const u16* Wt = (const u16*)(WIN8 + (size_t)f0 * D); const u16* At_ = (const u16*)((const unsigned char*)Hb + (size_t)rt * 256 * D);
                if (f0 >= 3072 && f0 < 4096) {
                    const int b = (rt < 128) ? (rt >> 4) : (rt - 128), key0 = (rt < 128) ? (rt & 15) * 256 : SEQ;
                    EpiV e{VT8 + ((size_t)b * 1024 + (f0 - 3072)) * SK + key0};
                    gemm_tile<true>(At_, D / 2, Wt, D / 2, D / 2, shm16, e);
                } else {
                    EpiG1 e; e.rope = ROPE; e.qscale = 1.f; e.wsc = 1.f / 32.f; e.lat = (rt < 128); e.t0 = (rt & 15) * 256; e.kind = 0;
                    const size_t r0 = (size_t)rt * 256;
                    if (f0 < 512) { e.out = POOLP + r0 * 512 + f0; e.ldo = 512; }
                    else if (f0 < 1024) { e.out = S5U + r0 * 512 + (f0 - 512); e.ldo = 512; }
                    else if (f0 < 2048) { e.out = Q8 + r0 * 1024 + (f0 - 1024); e.ldo = 1024; e.kind = 1; e.qscale = 4.f * 0.125f * 1.4426950408889634f; }
                    else if (f0 < 3072) { e.out = K8 + r0 * 1024 + (f0 - 2048); e.ldo = 1024; e.kind = 2; e.qscale = 0.25f; }
                    else { e.out = (unsigned char*)GATE + r0 * 6144 + (f0 - 4096); e.ldo = 6144; e.kind = 3; e.qscale = 128.f; }
                    if (GATES_FP4 && f0 >= 4096) {
                        e.wsc = 1.f / (G4_HS * G4_WS);
                        gemm_tile<2>((const u16*)(ws + WS_W4 + ((size_t)l * 6144 + (f0 - 4096)) * 1024), D / 4, (const u16*)(ws + WS_H4 + (size_t)rt * 256 * 1024), D / 4, D / 4, shm16, e);
                    } else
                    gemm_tile<true>(Wt, D / 2, At_, D / 2, D / 2, shm16, e);
                }
            }
            PH_SEAM(P0 + 1);
        }

        if (PH_IN(P0 + 2)) {
            PH_TID
            const long gt = (long)vb * 512 + tid, NGT = (long)G * 512;
            for (long i = gt; i < (long)Ract * 64; i += NGT) {
                const int ch = i & 63; const long r = i >> 6;
                const int gi = ch >> 4, win = 2 << gi;
                long base; int t, S;
                if (r < RL) { base = r & ~(long)(SEQ - 1); t = r & (SEQ - 1); S = SEQ; } else { base = RL + ((r - RL) & ~(long)(CTXL - 1)); t = (r - RL) & (CTXL - 1); S = CTXL; }
                const int lo_ = max(t - win / 2, 0), hi_ = min(t + win - 1 - win / 2, S - 1);
                float s[8];
#pragma unroll
                for (int e = 0; e < 8; ++e) s[e] = 0.f;
                uint4 wv[16];
#pragma unroll
                for (int j = 0; j < 16; ++j) { const int tt = min(lo_ + j, hi_); wv[j] = *(const uint4*)(POOLP + (base + tt) * 512 + ch * 8); }
#pragma unroll
                for (int j = 0; j < 16; ++j) if (lo_ + j <= hi_) { const uint4 v = wv[j];
                    s[0] += bflo(v.x); s[1] += bfhi(v.x); s[2] += bflo(v.y); s[3] += bfhi(v.y); s[4] += bflo(v.z); s[5] += bfhi(v.z); s[6] += bflo(v.w); s[7] += bfhi(v.w); }
                const float inv = 1.f / (float)(hi_ - lo_ + 1);
                const uint4 c = *(const uint4*)(POOLP + r * 512 + ch * 8);
                uint4 o;
                o.x = cvtpk(s[0] * inv - bflo(c.x), s[1] * inv - bfhi(c.x)); o.y = cvtpk(s[2] * inv - bflo(c.y), s[3] * inv - bfhi(c.y));
                o.z = cvtpk(s[4] * inv - bflo(c.z), s[5] * inv - bfhi(c.z)); o.w = cvtpk(s[6] * inv - bflo(c.w), s[7] * inv - bfhi(c.w));
                *(uint4*)(PD + r * 512 + ch * 8) = o;
            }
            for (long i = gt; i < 32l * 1088 * 64; i += NGT) {
                const int hf = i & 1, s = (i >> 1) & 31; const long gn = i >> 6; const int n = gn % 1088, g = gn / 1088;
                const long row = (n < 1024) ? ((long)(n >> 7) * SEQ + (n & 127) * S5L + s) : ((long)RL + ((n - 1024) >> 3) * CTXL + ((n - 1024) & 7) * S5L + s);
                *(uint4*)(UT + ((size_t)g * S5N + n) * S5K + s * 16 + hf * 8) = *(const uint4*)(S5U + row * 512 + g * 16 + hf * 8);
            }
            {
            const float* a_re = pin(11) + l * 4096; const float* a_im = pin(12) + l * 4096; const float* ldt = pin(13) + l * 64;
            const float* b_re = pin(14) + (size_t)l * 65536; const float* b_im = pin(15) + (size_t)l * 65536;
            const float* c_re = pin(16) + (size_t)l * 65536; const float* c_im = pin(17) + (size_t)l * 65536;
            const float* dsk = pin(18) + l * 512;
            {
                float* wre = (float*)lds;
                float* wim = wre + 2048;
                float* kdv = wim + 2048;
                for (int it = vb; it < 32 * 32; it += G) {
                    const int g = it >> 5, d = it & 31;
                    __syncthreads();
                    for (int i = tid; i < 2048; i += 512) {
                        const int dir = i >> 10, pp = (i >> 4) & 63, j = i & 15;
                        const int gi = (dir * 32 + g) * 64 + pp;
                        const float ar = a_re[gi], ai = a_im[gi], dt = expf(ldt[dir * 32 + g]);
                        float cr, ci, lr, li; s5_coef(ar, ai, dt, cr, ci); s5_lampow(ar, ai, dt, (float)d, lr, li);
                        const float br = b_re[(size_t)gi * 16 + j], bi = b_im[(size_t)gi * 16 + j];
                        const float bbr = cr * br - ci * bi, bbi = cr * bi + ci * br;
                        wre[i] = lr * bbr - li * bbi; wim[i] = lr * bbi + li * bbr;
                    }
                    __syncthreads();
                    const int dir = tid >> 8, ii = (tid >> 4) & 15, j = tid & 15;
                    const float* cr_ = c_re + ((size_t)(dir * 32 + g) * 16 + ii) * 64; const float* ci_ = c_im + ((size_t)(dir * 32 + g) * 16 + ii) * 64;
                    float kv = 0.f;
#pragma unroll 8
                    for (int pp = 0; pp < 64; ++pp) kv += cr_[pp] * wre[(dir * 64 + pp) * 16 + j] - ci_[pp] * wim[(dir * 64 + pp) * 16 + j];
                    kdv[tid] = kv;
                    __syncthreads();
                    u16* acg = AC + (size_t)g * 512 * S5K;
                    if (d == 0) {
                        if (dir == 0) { const float v = kdv[tid] + kdv[256 + tid] + ((ii == j) ? dsk[g * 16 + ii] : 0.f); const u16 hv = (u16)(cvtpk(v, 0.f) & 0xffff);
                            for (int t = 0; t < 32; ++t) acg[(size_t)(t * 16 + ii) * S5K + t * 16 + j] = hv; }
                    } else {
                        const u16 hv = (u16)(cvtpk(kv, 0.f) & 0xffff);
                        if (dir == 0) { for (int t = d; t < 32; ++t) acg[(size_t)(t * 16 + ii) * S5K + (t - d) * 16 + j] = hv; }
                        else { for (int t = 0; t < 32 - d; ++t) acg[(size_t)(t * 16 + ii) * S5K + (t + d) * 16 + j] = hv; }
                    }
                }
                __syncthreads();
            }
            {
                const long gt = (long)vb * 512 + tid, NGT = (long)G * 512;
                for (long i = gt; i < 32l * 512 * 256; i += NGT) {
                    const int col = i & 255, row = (i >> 8) & 511, g = i >> 17;
                    const int dir = col >> 7, im = (col >> 6) & 1, pp = col & 63, t = row >> 4, ii = row & 15;
                    const int gi = (dir * 32 + g) * 64 + pp;
                    const float dt = expf(ldt[dir * 32 + g]);
                    float lr, li; s5_lampow(a_re[gi], a_im[gi], dt, (dir == 0) ? (float)(t + 1) : (float)(32 - t), lr, li);
                    const float cr = c_re[((size_t)(dir * 32 + g) * 16 + ii) * 64 + pp], ci = c_im[((size_t)(dir * 32 + g) * 16 + ii) * 64 + pp];
                    const float v = im ? -(cr * li + ci * lr) : (cr * lr - ci * li);
                    AC[((size_t)g * 512 + row) * S5K + 512 + col] = (u16)(cvtpk(v, 0.f) & 0xffff);
                }
                for (long i = gt; i < 32l * 256 * 512; i += NGT) {
                    const int col = i & 511, row = (i >> 9) & 255, g = i >> 17;
                    const int dir = row >> 7, im = (row >> 6) & 1, pp = row & 63, s = col >> 4, j = col & 15;
                    const int gi = (dir * 32 + g) * 64 + pp;
                    const float ar = a_re[gi], ai = a_im[gi], dt = expf(ldt[dir * 32 + g]);
                    float cr, ci, lr, li; s5_coef(ar, ai, dt, cr, ci); s5_lampow(ar, ai, dt, (dir == 0) ? (float)(31 - s) : (float)s, lr, li);
                    const float br = b_re[(size_t)gi * 16 + j], bi = b_im[(size_t)gi * 16 + j];
                    const float bbr = cr * br - ci * bi, bbi = cr * bi + ci * br;
                    const float v = im ? (lr * bbi + li * bbr) : (lr * bbr - li * bbi);
                    AE[((size_t)g * 256 + row) * 512 + col] = (u16)(cvtpk(v, 0.f) & 0xffff);
                }
            }
            }
            PH_SEAM(P0 + 2);
        }

        if (PH_IN(P0 + 3)) {
            PH_TID
            const u16* WPOOL = (const u16*)(ws + WS_WPOOL) + (size_t)l * 512 * 512;
            const int NT_POOL = 2 * (Ract / 256); constexpr int NT_E = 32 * 5;
            for (int t = vb; t < NT_POOL; t += G) {
                const int ct = t & 1, rt = t >> 1;
                EpiPool e{YPOOL + (size_t)rt * 256 * 512 + ct * 256, pin(10) + l * 512 + ct * 256};
                gemm_tile<false>(WPOOL + (size_t)ct * 256 * 512, 512, PD + (size_t)rt * 256 * 512, 512, 512, shm16, e);
            }
            for (int u = (vb + G - (NT_POOL % G)) % G; u < NT_E; u += G) {
                const int g = u / 5, nt = u % 5;
                EpiS5E e{EB + ((size_t)g * S5N + nt * 256) * 256};
                gemm_tile<false>(AE + (size_t)g * 256 * 512, 512, UT + ((size_t)g * S5N + nt * 256) * S5K, S5K, 512, shm16, e);
            }
            PH_SEAM(P0 + 3);
        }

        if (PH_IN(P0 + 4)) {
            PH_TID
            int vbs = vb; asm volatile("" : "+s"(vbs));
            if (vbs < 64) {
                const int gi = vbs * 512 + tid; const int pp = gi & 63, dir = (gi >> 6) & 1, g = (gi >> 7) & 31, b = gi >> 12;
                const int pi = (dir * 32 + g) * 64 + pp;
                const float dt = expf(pin(13)[l * 64 + dir * 32 + g]);
                float Lr, Li; s5_lampow(pin(11)[l * 4096 + pi], pin(12)[l * 4096 + pi], dt, 32.f, Lr, Li);
                float hr = 0.f, hi_ = 0.f;
                for (int st0 = 0; st0 < 136; st0 += 17) {
                    float er[17], ei[17]; size_t gnv[17];
#pragma unroll
                    for (int j = 0; j < 17; ++j) {
                        const int st = st0 + j; int n;
                        if (dir == 0) n = (st < 8) ? (1024 + b * 8 + st) : (b * 128 + (st - 8));
                        else n = (st < 8) ? (1024 + b * 8 + (7 - st)) : (b * 128 + (135 - st));
                        gnv[j] = (size_t)g * S5N + n;
                        er[j] = EB[gnv[j] * 256 + dir * 128 + pp]; ei[j] = EB[gnv[j] * 256 + dir * 128 + 64 + pp];
                    }
#pragma unroll
                    for (int j = 0; j < 17; ++j) {
                        u16* ho = UT + gnv[j] * S5K + 512 + dir * 128 + pp;
                        ho[0] = (u16)(cvtpk(hr, 0.f) & 0xffff); ho[64] = (u16)(cvtpk(hi_, 0.f) & 0xffff);
                        const float nr = Lr * hr - Li * hi_ + er[j], ni = Lr * hi_ + Li * hr + ei[j];
                        hr = nr; hi_ = ni;
                    }
                }
            }
            float s1 = 0.f, s2 = 0.f;
            { s1 = pin(20)[l * 64 + lane] * pin(21)[l * 64 + lane]; s2 = pin(22)[l * 64 + lane] * pin(23)[l * 64 + lane];
#pragma unroll
              for (int of = 32; of > 0; of >>= 1) { s1 += __shfl_xor(s1, of); s2 += __shfl_xor(s2, of); } }
            const float lam = expf(s1) - expf(s2) + lam_init;
            const int nunits = 2048 + ((l == 0) ? 128 : 0);
            attn_prep((char*)lds);
            const bool shiftc = (l == 0) && (G == 256);
            for (int u0 = vb; u0 < nunits + (shiftc ? 128 : 0); u0 += G) {
                int u = u0;
                if (shiftc && u0 >= 2048) { if (u0 < 2048 + 128) continue; u = u0 - 128; }
                int b, hd, qrow0, k_lo;
                if (u < 2048) { b = u >> 8; hd = (u >> 5) & 7; qrow0 = b * SEQ + (u & 31) * 128; k_lo = 0; }
                else { const int v = u - 2048; b = v >> 4; hd = (v >> 1) & 7; qrow0 = RL + b * CTXL + (v & 1) * 128; k_lo = 32; }
                attn_unit(Q8, K8, VT8, YATT, b, hd, qrow0, k_lo, 34, lam, 1.f - lam_init, pin(24) + l * 128, (char*)lds);
            }
            PH_SEAM(P0 + 4);
        }

        if (PH_IN(P0 + 5)) {
            PH_TID
            const int ntn = (l == 0) ? 10 : 8;
            for (int t = vb; t < 32 * ntn; t += G) {
                const int g = t / ntn, r = t % ntn, it = r & 1, nt = r >> 1;
                EpiS5Y e{YG, g, it, nt};
                gemm_tile<false>(AC + ((size_t)g * 512 + it * 256) * S5K, S5K, UT + ((size_t)g * S5N + nt * 256) * S5K, S5K, S5K, shm16, e);
            }
            PH_SEAM(P0 + 5);
        }

        if (PH_IN(P0 + 6)) {
            PH_TID
            const u16* WGLU = (const u16*)(ws + WS_WGLU) + (size_t)l * 512 * 512;
            for (int t = vb; t < 2 * (Ract / 256); t += G) {
                const int ct = t & 1, rt = t >> 1;
                const size_t o = (size_t)rt * 256 * 512 + ct * 256;
                EpiGlu e{YS5 + o, YG + o};
                gemm_tile<false>(WGLU + (size_t)ct * 256 * 512, 512, YG + (size_t)rt * 256 * 512, 512, 512, shm16, e);
            }
            PH_SEAM(P0 + 6);
        }

        if (PH_IN(P0 + 7)) {
            PH_TID
            constexpr int NTI = 8, GM = 8; const int NTJ = Ract / 256;
            for (int t = vb; t < NTI * NTJ; t += G) {
                const int grp = t / (GM * NTI), rem = t % (GM * NTI), rt = grp * GM + rem % GM, ct = rem / GM;
                const size_t r0 = (size_t)rt * 256; const int n0 = ct * 256;
                Acc macc = {};
#pragma unroll 1
                for (int br = 0; br < 3; ++br) {
                    EpiMerge e{MERGED8 + r0 * D + n0, (const unsigned char*)GATE + r0 * 6144 + br * 2048 + n0, br};
                    const u16* Wt = (const u16*)(WBR8 + (size_t)n0 * D + ((br == 0) ? 0 : (br == 1) ? 512 : 1024));
                    const u16* Ab = (const u16*)((br == 0) ? YPOOL + r0 * 512 : (br == 1) ? YS5 + r0 * 512 : YATT + r0 * 1024);
                    gemm_tile_acc<true>(Wt, D / 2, Ab, (br == 2) ? 512 : 256, (br == 2) ? 512 : 256, shm16, macc, e);
                }
            }
            if (l == 0 && G == 256 && vb >= 64)
                peer_tables_fp4((const float4*)pin(31), (const float4*)pin(32), U8, V8, 0, 16384l * D / 64, (long)(vb - 64) * 512 + tid, 192l * 512);
            PH_SEAM(P0 + 7);
        }

        if (PH_IN(P0 + 8)) {
            PH_TID
            constexpr int NTI = 8, GM = 8; const int NTJ = Ract / 256;
            for (int t = vb; t < NTI * NTJ; t += G) {
                const int grp = t / (GM * NTI), rem = t % (GM * NTI), rt = grp * GM + rem % GM, ct = rem / GM;
                const size_t r0 = (size_t)rt * 256; const int n0 = ct * 256;
                const int bb = (rt < 128) ? (rt >> 4) : 8;
                const void* xin = (rt < 128) ? ((l == 0) ? (const void*)(pin(0) + r0 * D + n0) : (const void*)(XB + r0 * D + n0)) : (const void*)(xc_in + (r0 - RL) * D + n0);
                void* xout = (rt < 128) ? (void*)(XB + r0 * D + n0) : (void*)(XC + (r0 - RL) * D + n0);
                EpiRes e{xin, xout, mods + bb * 12288 + 2 * D + n0, 1.f / 128.f, (rt < 128) && (l == 1), (rt < 128)};
                gemm_tile<true>((const u16*)(WOUT8 + (size_t)n0 * D), D / 2, (const u16*)(MERGED8 + r0 * D), D / 2, D / 2, shm16, e);
            }
            if (l == 0 && G == 256 && vb >= 64)
                peer_tables_fp4((const float4*)pin(31), (const float4*)pin(32), U8, V8, 16384l * D / 64, 16384l * D / 32, (long)(vb - 64) * 512 + tid, 192l * 512);
            PH_SEAM(P0 + 8);
        }

        if (PH_IN(P0 + 9)) {
            PH_TID
            for (int r = vb * 8 + wave; r < Ract; r += G * 8) {
                const int bb = (r < RL) ? (r >> 12) : 8;
                if (r < RL) rms_mod_row<false, true>(XB + (size_t)r * D, pin(7) + l * D, mods + bb * 12288 + 3 * D, mods + bb * 12288 + 4 * D, Hb + (size_t)r * D, lane, nullptr, MERGED8 + (size_t)r * D);
                else rms_mod_row<false, false>(XC + (size_t)(r - RL) * D, pin(7) + l * D, mods + bb * 12288 + 3 * D, mods + bb * 12288 + 4 * D, Hb + (size_t)r * D, lane, nullptr, MERGED8 + (size_t)r * D);
            }
            const long gt = (long)vb * 512 + tid, NGT = (long)G * 512;
            for (long i = gt; i < 9l * 3 * 2048; i += NGT) {
                const int b9 = (int)(i / 6144), vs_ = (int)(i / 2048) % 3, pp = (int)(i & 2047);
                const int c = ((pp >> 2) & 63) * 32 + (pp >> 8) * 4 + (pp & 3);
                float val;
                if (vs_ == 0) val = mods[b9 * 12288 + 5 * D + c];
                else if (l == 0) { const float* m1 = MODS + (size_t)9 * 12288 + b9 * 12288; val = (vs_ == 1) ? pin(6)[D + c] * (1.f + m1[D + c]) : m1[c]; }
                else val = pin(33)[c];
                ((float*)(ws + WS_PERM))[i] = val;
            }
            const float4* us = (const float4*)(pin(31) + (size_t)l * 16384 * D); const float4* vs = (const float4*)(pin(32) + (size_t)l * 16384 * D);
            if (!(l == 0 && G == 256)) peer_tables_fp4(us, vs, U8, V8, 0, 16384l * D / 32, gt, NGT);
            PH_SEAM(P0 + 9);
        }

        if (PH_IN(P0 + 10)) {
            PH_TID
            constexpr int NTI = 8, GM = 8; const int NTJ = Ract / 256;
            for (int t = vb; t < NTI * NTJ; t += G) {
                const int grp = t / (GM * NTI), rem = t % (GM * NTI), rt = grp * GM + rem % GM, ct = rem / GM;
                const size_t r0 = (size_t)rt * 256; const int n0 = ct * 256;
                EpiF16 e{SCORES + r0 * 2048 + n0, 1.f / 32.f};
                gemm_tile<1>((const u16*)(WPK8 + (size_t)n0 * D), D / 2, (const u16*)(MERGED8 + r0 * D), D / 2, D / 2, shm16, e);
            }
            PH_SEAM(P0 + 10);
        }

        if (PH_IN(P0 + 11)) {
            PH_TID
            const long gt = (long)vb * 512 + tid, NGT = (long)G * 512;
            for (long i = gt; i < (long)Ract * 8; i += NGT) {
                const u32x4* sc = (const u32x4*)(SCORES + i * 256);
                unsigned L1[16], L2[16];
#pragma unroll
                for (int k = 0; k < 16; ++k) { L1[k] = 0u; L2[k] = 0u; }
#pragma unroll 1
                for (int gq = 0; gq < 8; ++gq) {
                    const u32x4 a0 = sc[2 * gq], a1 = sc[2 * gq + 1], c0 = sc[16 + 2 * gq], c1 = sc[16 + 2 * gq + 1];
                    unsigned B1[16], B2[16];
#pragma unroll
                    for (int d = 0; d < 4; ++d) {
                        const unsigned x0 = a0[d], x1 = a1[d], y0 = c0[d], y1 = c1[d];
                        const h16x2 xa = __builtin_bit_cast(h16x2, x0), xb = __builtin_bit_cast(h16x2, x1), ya = __builtin_bit_cast(h16x2, y0), yb = __builtin_bit_cast(h16x2, y1);
                        const unsigned id = (unsigned)(16 * gq + 2 * d);
                        B1[2 * d] = (fenc((float)xa[0]) & ~127u) | id; B1[2 * d + 1] = (fenc((float)xa[1]) & ~127u) | (id + 1);
                        B1[8 + 2 * d] = (fenc((float)xb[0]) & ~127u) | (id + 8); B1[8 + 2 * d + 1] = (fenc((float)xb[1]) & ~127u) | (id + 9);
                        B2[2 * d] = (fenc((float)ya[0]) & ~127u) | id; B2[2 * d + 1] = (fenc((float)ya[1]) & ~127u) | (id + 1);
                        B2[8 + 2 * d] = (fenc((float)yb[0]) & ~127u) | (id + 8); B2[8 + 2 * d + 1] = (fenc((float)yb[1]) & ~127u) | (id + 9);
                    }
                    sort16_desc(B1); merge16_desc(L1, B1);
                    sort16_desc(B2); merge16_desc(L2, B2);
                }
                unsigned T[16];
#pragma unroll
                for (int k = 0; k < 16; ++k) T[k] = 0u;
#pragma unroll
                for (int a = 0; a < 16; ++a) {
                    const float va = fdec(L1[a] & ~127u); const unsigned ia = L1[a] & 127u;
#pragma unroll
                    for (int c = 0; c < 16; ++c) {
                        if ((a + 1) * (c + 1) <= 16) {
                            const float vs = va + fdec(L2[c] & ~127u);
                            INS32(T, (fenc(vs) & ~0x3FFFu) | (ia << 7) | (L2[c] & 127u));
                        }
                    }
                }
                float w[16]; float sum = 0.f; const float mx = fdec(T[0] & ~0x3FFFu);
#pragma unroll
                for (int k = 0; k < 16; ++k) { w[k] = __expf(fdec(T[k] & ~0x3FFFu) - mx); sum += w[k]; }
                const float inv = 1.f / sum;
                int4* eo = (int4*)(EL + i * 16); float4* go = (float4*)(GL + i * 16);
#pragma unroll
                for (int k = 0; k < 4; ++k) {
                    eo[k] = make_int4((int)(T[4 * k] & 0x3FFFu), (int)(T[4 * k + 1] & 0x3FFFu), (int)(T[4 * k + 2] & 0x3FFFu), (int)(T[4 * k + 3] & 0x3FFFu));
                    go[k] = make_float4(w[4 * k] * inv, w[4 * k + 1] * inv, w[4 * k + 2] * inv, w[4 * k + 3] * inv);
                }
            }
            PH_SEAM(P0 + 11);
        }

        if (PH_IN(P0 + 12)) {
            PH_TID
            for (int r = vb * 8 + wave; r < Ract; r += G * 8) {
                const int e0 = EL[(size_t)r * 128 + lane], e1 = EL[(size_t)r * 128 + 64 + lane];
                const float g0 = GL[(size_t)r * 128 + lane], g1 = GL[(size_t)r * 128 + 64 + lane];
                h16x2 hh[16];
                {
                    const u16* hrow = Hb + (size_t)r * D + lane * 32;
#pragma unroll
                    for (int c4 = 0; c4 < 4; ++c4) { const u32x4 t4 = *(const u32x4*)(hrow + c4 * 8);
#pragma unroll
                        for (int d = 0; d < 4; ++d) hh[c4 * 4 + d] = (h16x2){(_Float16)bflo(t4[d]), (_Float16)bfhi(t4[d])}; }
                }
                float w0 = 0.f, w1 = 0.f;
#pragma unroll 1
                for (int hd = 0; hd < 8; ++hd) {
                    const int esel = (hd < 4) ? e0 : e1; const int lb = (hd & 3) * 16;
                    u32x4 ua[16];
#pragma unroll
                    for (int k = 0; k < 16; ++k) { const int ek = __builtin_amdgcn_readlane(esel, lb + k); ua[k] = *(const u32x4*)(U8 + (size_t)ek * (D / 2) + lane * 16); }
                    float part[16];
#pragma unroll
                    for (int k = 0; k < 16; ++k) {
                        h16x2 acc = (h16x2){(_Float16)0.f, (_Float16)0.f};
#pragma unroll
                        for (int d = 0; d < 4; ++d) {
                            acc = __builtin_elementwise_fma(CVT4H(ua[k][d], 0), hh[4 * d + 0], acc);
                            acc = __builtin_elementwise_fma(CVT4H(ua[k][d], 1), hh[4 * d + 1], acc);
                            acc = __builtin_elementwise_fma(CVT4H(ua[k][d], 2), hh[4 * d + 2], acc);
                            acc = __builtin_elementwise_fma(CVT4H(ua[k][d], 3), hh[4 * d + 3], acc);
                        }
                        part[k] = (float)acc[0] + (float)acc[1];
                    }
                    float p8[8], p4[4], p2[2], p1;
#pragma unroll
                    for (int k = 0; k < 8; ++k) { const auto x_ = __builtin_amdgcn_permlane32_swap(__float_as_uint(part[k]), __float_as_uint(part[8 + k]), false, false);
                        p8[k] = __uint_as_float(x_[0]) + __uint_as_float(x_[1]); }
#pragma unroll
                    for (int k = 0; k < 4; ++k) { const auto x_ = __builtin_amdgcn_permlane16_swap(__float_as_uint(p8[k]), __float_as_uint(p8[4 + k]), false, false);
                        p4[k] = __uint_as_float(x_[0]) + __uint_as_float(x_[1]); }
                    { const bool up_ = lane & 8;
#pragma unroll
                      for (int k = 0; k < 2; ++k) { const float keep = up_ ? p4[2 + k] : p4[k], send = up_ ? p4[k] : p4[2 + k]; p2[k] = keep + __shfl_xor(send, 8); } }
                    { const bool up_ = lane & 4; const float keep = up_ ? p2[1] : p2[0], send = up_ ? p2[0] : p2[1]; p1 = keep + __shfl_xor(send, 4); }
                    p1 += __shfl_xor(p1, 2); p1 += __shfl_xor(p1, 1);
                    const float tv = __shfl(p1, 4 * (lane & 15));
                    if ((lane >> 4) == (hd & 3)) { if (hd < 4) w0 = tv; else w1 = tv; }
                }
                GL[(size_t)r * 128 + lane] = g0 * gelu_tanh(w0 * (1.f / PEER_USC)); GL[(size_t)r * 128 + 64 + lane] = g1 * gelu_tanh(w1 * (1.f / PEER_USC));
            }
            PH_SEAM(P0 + 12);
        }

        if (PH_IN(P0 + 13)) {
            PH_TID
            for (int r = vb * 8 + wave; r < Ract; r += G * 8) {
                const int bb = (r < RL) ? (r >> 12) : 8;
                const int e0 = EL[(size_t)r * 128 + lane], e1 = EL[(size_t)r * 128 + 64 + lane];
                const float w0 = GL[(size_t)r * 128 + lane], w1 = GL[(size_t)r * 128 + 64 + lane];
                h16x2 oo[16];
#pragma unroll
                for (int i = 0; i < 16; ++i) oo[i] = (h16x2){(_Float16)0.f, (_Float16)0.f};
#pragma unroll 1
                for (int hd = 0; hd < 8; ++hd) {
                    const int esel = (hd < 4) ? e0 : e1; const float wsel = (hd < 4) ? w0 : w1; const int lb = (hd & 3) * 16;
                    u32x4 va[16]; float wk[16];
#pragma unroll
                    for (int k = 0; k < 16; ++k) {
                        wk[k] = __int_as_float(__builtin_amdgcn_readlane(__float_as_int(wsel), lb + k));
                        const int ek = __builtin_amdgcn_readlane(esel, lb + k);
                        va[k] = *(const u32x4*)(V8 + (size_t)ek * (D / 2) + lane * 16);
                    }
#pragma unroll
                    for (int k = 0; k < 16; ++k) {
                        const _Float16 wh = (_Float16)wk[k]; const h16x2 w2 = (h16x2){wh, wh};
#pragma unroll
                        for (int d = 0; d < 4; ++d) {
                            oo[4 * d + 0] = __builtin_elementwise_fma(CVT4H(va[k][d], 0), w2, oo[4 * d + 0]);
                            oo[4 * d + 1] = __builtin_elementwise_fma(CVT4H(va[k][d], 1), w2, oo[4 * d + 1]);
                            oo[4 * d + 2] = __builtin_elementwise_fma(CVT4H(va[k][d], 2), w2, oo[4 * d + 2]);
                            oo[4 * d + 3] = __builtin_elementwise_fma(CVT4H(va[k][d], 3), w2, oo[4 * d + 3]);
                        }
                    }
                }
                const bool lat = r < RL;
                float* xr = XC + (size_t)(lat ? 0 : r - RL) * D + lane * 32;
                u16* xb = XB + (size_t)(lat ? r : 0) * D + lane * 32;
                const float* pvec = (const float*)(ws + WS_PERM) + (size_t)bb * 6144 + lane * 4;
                float4 xv[8]; float ss = 0.f;
                if (lat) {
#pragma unroll
                    for (int c = 0; c < 4; ++c) { const u32x4 t = *(const u32x4*)(xb + c * 8); const unsigned t0 = t[0], t1 = t[1], t2 = t[2], t3 = t[3];
                        xv[2 * c] = make_float4(bflo(t0), bfhi(t0), bflo(t1), bfhi(t1)); xv[2 * c + 1] = make_float4(bflo(t2), bfhi(t2), bflo(t3), bfhi(t3)); }
                } else {
#pragma unroll
                    for (int q4 = 0; q4 < 8; ++q4) xv[q4] = *(const float4*)(xr + q4 * 4);
                }
#pragma unroll
                for (int q4 = 0; q4 < 8; ++q4) {
                    float4 x = xv[q4]; const float4 gg = *(const float4*)(pvec + q4 * 256);
                    x.x += gg.x * (float)oo[2 * q4][0] * (1.f / PEER_VSC); x.y += gg.y * (float)oo[2 * q4][1] * (1.f / PEER_VSC); x.z += gg.z * (float)oo[2 * q4 + 1][0] * (1.f / PEER_VSC); x.w += gg.w * (float)oo[2 * q4 + 1][1] * (1.f / PEER_VSC);
                    xv[q4] = x; ss += x.x * x.x + x.y * x.y + x.z * x.z + x.w * x.w;
                }
#pragma unroll
                for (int of = 32; of > 0; of >>= 1) ss += __shfl_xor(ss, of);
                const float inv = rsqrtf(ss * (1.f / 2048.f) + 1e-6f);
                if (l == 0) {
                    unsigned* ho = (unsigned*)((unsigned char*)Hb + (size_t)r * D + lane * 32);
                    if (lat) {
#pragma unroll
                        for (int c = 0; c < 4; ++c) { u32x4 t; t[0] = cvtpk(xv[2 * c].x, xv[2 * c].y); t[1] = cvtpk(xv[2 * c].z, xv[2 * c].w); t[2] = cvtpk(xv[2 * c + 1].x, xv[2 * c + 1].y); t[3] = cvtpk(xv[2 * c + 1].z, xv[2 * c + 1].w);
                            *(u32x4*)(xb + c * 8) = t; }
                    } else {
#pragma unroll
                        for (int q4 = 0; q4 < 8; ++q4) *(float4*)(xr + q4 * 4) = xv[q4];
                    }
                    unsigned hq[8], h4q[4];
#pragma unroll
                    for (int q4 = 0; q4 < 8; ++q4) {
                        const float4 ga = *(const float4*)(pvec + 2048 + q4 * 256), sh = *(const float4*)(pvec + 4096 + q4 * 256);
                        const float y0 = xv[q4].x * inv * ga.x + sh.x, y1 = xv[q4].y * inv * ga.y + sh.y, y2 = xv[q4].z * inv * ga.z + sh.z, y3 = xv[q4].w * inv * ga.w + sh.w;
                        hq[q4] = pack4f8(y0, y1, y2, y3);
                        unsigned f4;
                        if ((q4 & 1) == 0) { f4 = __builtin_amdgcn_cvt_scalef32_pk_fp4_f32(0u, y0 * G4_HS, y1 * G4_HS, 1.0f, 0); f4 = __builtin_amdgcn_cvt_scalef32_pk_fp4_f32(f4, y2 * G4_HS, y3 * G4_HS, 1.0f, 1); }
                        else { f4 = __builtin_amdgcn_cvt_scalef32_pk_fp4_f32(h4q[q4 >> 1], y0 * G4_HS, y1 * G4_HS, 1.0f, 2); f4 = __builtin_amdgcn_cvt_scalef32_pk_fp4_f32(f4, y2 * G4_HS, y3 * G4_HS, 1.0f, 3); }
                        h4q[q4 >> 1] = f4;
                    }
                    if (GATES_FP4) *(u32x4*)(ws + WS_H4 + (size_t)r * 1024 + lane * 16) = (u32x4){h4q[0], h4q[1], h4q[2], h4q[3]};
                    *(u32x4*)(ho) = (u32x4){hq[0], hq[1], hq[2], hq[3]}; *(u32x4*)(ho + 4) = (u32x4){hq[4], hq[5], hq[6], hq[7]};
                } else {
                    float* ob = (float*)lds + (size_t)wave * (64 * 36);
#pragma unroll
                    for (int q4 = 0; q4 < 8; ++q4) { const float4 gn = *(const float4*)(pvec + 2048 + q4 * 256);
                        *(float4*)(ob + lane * 36 + q4 * 4) = make_float4(xv[q4].x * inv * gn.x, xv[q4].y * inv * gn.y, xv[q4].z * inv * gn.z, xv[q4].w * inv * gn.w); }
                    float* op = p.out + (size_t)r * D + lane * 4;
#pragma unroll
                    for (int k = 0; k < 8; ++k) {
                        *(float4*)(op + k * 256) = *(const float4*)(ob + (k * 8 + (lane >> 3)) * 36 + (lane & 7) * 4); }
                }
            }
            PH_SEAM(P0 + 13);
        }
    }

}

extern "C" void kernel_launch(void* const* d_in, const int* in_sizes, int n_in, void* d_out, int out_size, void* d_ws, size_t ws_size, hipStream_t stream) {
    static int grid = 0;
    if (grid == 0) {
        if (n_in != 34 || out_size != RL * D || ws_size < WS_END) { fprintf(stderr, "kernel_launch: unexpected shapes (n_in %d out %d ws %zu need %zu)\n", n_in, out_size, ws_size, (size_t)WS_END); grid = -1; return; }
        int dev = 0, cus = 0;
        if (hipGetDevice(&dev) != hipSuccess || hipDeviceGetAttribute(&cus, hipDeviceAttributeMultiprocessorCount, dev) != hipSuccess) { grid = -1; return; }
        if (hipFuncSetAttribute((const void*)fwd_kernel, hipFuncAttributeMaxDynamicSharedMemorySize, LDS_BYTES) != hipSuccess) { fprintf(stderr, "kernel_launch: hipFuncSetAttribute failed\n"); grid = -1; return; }
        int per_cu = 0;
        if (hipOccupancyMaxActiveBlocksPerMultiprocessor(&per_cu, (const void*)fwd_kernel, 512, LDS_BYTES) != hipSuccess || per_cu < 1) { fprintf(stderr, "kernel_launch: occupancy query says %d\n", per_cu); }
        (void)hipGetLastError();
        grid = cus;
    }
    if (grid < 0) return;
    (void)hipMemsetAsync((char*)d_ws + WS_CTL, 0, 16384, stream);
    Params p{};
    for (int i = 0; i < 34; ++i) p.in[i] = (const float*)d_in[i];
    p.out = (float*)d_out; p.ws = (unsigned char*)d_ws;
#if ONE_LAUNCH
    p.ph_lo = 0; p.ph_hi = NPHASE;
    hipLaunchKernelGGL(fwd_kernel, dim3(grid), dim3(512), LDS_BYTES, stream, p);
#else
    for (int ph = 0; ph < NPHASE; ++ph) { p.ph_lo = ph; p.ph_hi = ph + 1; hipLaunchKernelGGL(fwd_kernel, dim3(grid), dim3(512), LDS_BYTES, stream, p); }
#endif
}
```

```cpp
#include <hip/hip_runtime.h>
#include <stdint.h>
#include <stdio.h>

#ifndef ONE_LAUNCH
#define ONE_LAUNCH 1
#endif
#define PEER_USC 90.f
#define PEER_VSC 2.f
#ifndef GATES_FP4
#define GATES_FP4 1
#endif
#define G4_HS 1.5f
#define G4_WS 90.f

typedef unsigned short u16;
typedef __attribute__((ext_vector_type(8))) short bf16x8;
typedef __attribute__((ext_vector_type(4))) float f32x4;
typedef __attribute__((ext_vector_type(2))) __bf16 bf16x2v;
typedef __attribute__((ext_vector_type(4))) unsigned u32x4;
typedef __attribute__((ext_vector_type(2))) float f32x2;
typedef __attribute__((ext_vector_type(2))) _Float16 h16x2;
#define CVT4H(p, sel) __builtin_bit_cast(h16x2, __builtin_amdgcn_cvt_scalef32_pk_f16_fp4((p), 1.0f, (sel)))
typedef __attribute__((ext_vector_type(8))) int v8i;
typedef __attribute__((ext_vector_type(4))) int v4i;

constexpr int D = 2048, NB = 8, SEQ = 4096, CTXL = 256;
constexpr int RL = NB * SEQ, RC = NB * CTXL, R = RL + RC;
constexpr int NIN = 10240, SK = SEQ + CTXL;
constexpr int NPL = 14;
constexpr int NPHASE = 1 + 2 * NPL;
constexpr int S5L = 32, S5N = 1280, S5K = 768;
constexpr int LDS_BYTES = 139264;
constexpr int BAR_LDS_OFF = 131072;

constexpr size_t MB = 1ull << 20;
constexpr size_t al(size_t x) { return (x + 255) & ~(size_t)255; }
constexpr size_t WS_CTL = 0;
constexpr size_t WS_MODS = 65536;
constexpr size_t WS_ROPE = WS_MODS + al(2ull * 9 * 12288 * 4);
constexpr size_t WS_XC = WS_ROPE + al(64 * 16 * 8);
constexpr size_t WS_WIN = WS_XC + al((size_t)RC * D * 4);
constexpr size_t WS_WBR = WS_WIN + al(2ull * NIN * D * 2);
constexpr size_t WS_WOUT = WS_WBR + al(2ull * D * D * 2);
constexpr size_t WS_WPK = WS_WOUT + al(2ull * D * D * 2);
constexpr size_t WS_WQ16 = WS_WPK + al(2ull * D * D * 2);
constexpr size_t WS_KPAD = WS_WQ16 + al(2ull * D * D * 2);
constexpr size_t WS_WGLU = WS_KPAD + al(2ull * 8 * 256 * 256 * 2);
constexpr size_t WS_WPOOL = WS_WGLU + al(2ull * 512 * 512 * 2);
constexpr size_t WS_AC = WS_WPOOL + al(2ull * 512 * 512 * 2);
constexpr size_t WS_AE = WS_AC + al(32ull * 512 * S5K * 2);
constexpr size_t WS_H = WS_AE + al(32ull * 256 * 512 * 2);
constexpr size_t WS_PD = WS_H;
constexpr size_t WS_UT = WS_PD + al((size_t)R * 512 * 2);
constexpr size_t WS_YG = WS_UT + al(32ull * S5N * S5K * 2);
constexpr size_t WS_PROJ = WS_H + al((size_t)R * D * 2);
constexpr size_t WS_POOLP = WS_PROJ;
constexpr size_t WS_S5U = WS_POOLP + al((size_t)R * 512 * 2);
constexpr size_t WS_Q = WS_S5U + al((size_t)R * 512 * 2);
constexpr size_t WS_K = WS_Q + al((size_t)R * 1024 * 2);
constexpr size_t WS_VT = WS_K + al((size_t)R * 1024 * 2);
constexpr size_t WS_GATE = WS_VT + al((size_t)NB * 1024 * SK * 2);
constexpr size_t WS_YPOOL = WS_GATE + al((size_t)R * 6144 * 2);
constexpr size_t WS_YS5 = WS_YPOOL + al((size_t)R * 512 * 2);
constexpr size_t WS_YATT = WS_YS5 + al((size_t)R * 512 * 2);
constexpr size_t WS_END = WS_YATT + al((size_t)R * 1024 * 2);
constexpr size_t WS_XB = WS_GATE + al((size_t)R * 6144);
static_assert(WS_XB + (size_t)RL * D * 2 <= WS_YPOOL, "bf16 residual stream fits behind the fp8 gates");
constexpr size_t WS_PERM = WS_WIN + 2ull * NIN * D;
constexpr size_t WS_W4 = WS_PERM + 262144;
static_assert(WS_W4 + 2ull * 6144 * 1024 <= WS_WBR, "permuted modulation vectors and fp4 gate weights fit behind the fp8 in-projection weights");
constexpr size_t WS_H4 = WS_XB + al((size_t)RL * D * 2);
static_assert(WS_H4 + (size_t)R * 1024 <= WS_YPOOL, "fp4 h fits behind the bf16 residual stream");
constexpr size_t WS_E = WS_POOLP;
constexpr size_t WS_SCORES = WS_GATE;
constexpr size_t WS_EL = WS_POOLP;
constexpr size_t WS_GL = WS_S5U;
constexpr size_t WS_U16 = WS_Q;
constexpr size_t WS_V16 = WS_K;
static_assert(32ull * S5N * 256 * 4 <= 2 * al((size_t)R * 512 * 2), "E fits");
static_assert(16384ull * 2048 * 2 <= al((size_t)R * 1024 * 2), "peer table fits");
static_assert((size_t)R * 4096 <= WS_END - WS_YPOOL, "fp8 branch outputs + merged fit");
static_assert((size_t)R * 512 * 2 + 32ull * S5N * S5K * 2 + (size_t)R * 512 * 2 <= (size_t)R * D * 2, "PD/UT/YG fit in H");

#define XB_TMO      128
#define XB_XCNT(j)  (256  + 64 * (j))
#define XB_XSUB(j)  (1280 + 64 * (j))
#define XB_XGEN(j)  (2304 + 64 * (j))
#define XB_TOP      3328
#define XB_TOPGEN   3392
#define XCD_BAR_WORDS 3456
#define XB_SPIN_CAP (1u << 20)
#define LAS __attribute__((address_space(3)))
__device__ __forceinline__ unsigned xb_ld(unsigned* p)              { return __hip_atomic_load(p, __ATOMIC_RELAXED, __HIP_MEMORY_SCOPE_AGENT); }
__device__ __forceinline__ unsigned xb_add(unsigned* p, unsigned v) { return __hip_atomic_fetch_add(p, v, __ATOMIC_RELAXED, __HIP_MEMORY_SCOPE_AGENT); }
__device__ __forceinline__ unsigned xb_xcc_id() { return (unsigned)__builtin_amdgcn_s_getreg((3 << 11) | 20) & 0xFu; }
#define XB_SPIN(cond, bar) do { unsigned _sp = 0; while (cond) { __builtin_amdgcn_s_sleep(1); \
    if ((++_sp & 255u) == 0u) { if (xb_ld(&(bar)[XB_TMO])) break; if (_sp > XB_SPIN_CAP) { atomicAdd(&(bar)[XB_TMO], 1u); break; } } } } while (0)
struct XcdBarrier { unsigned* bar; unsigned x; volatile LAS unsigned* st; };
__device__ __forceinline__ XcdBarrier xcd_barrier_post(unsigned* bar, volatile LAS unsigned* st) {
    XcdBarrier b; b.bar = bar; b.x = xb_xcc_id(); b.st = st;
    if (threadIdx.x == 0) (void)xb_add(&bar[XB_XCNT(b.x)], 1u);
    return b;
}
__device__ __forceinline__ void xcd_barrier_complete(unsigned* bar, unsigned x, unsigned& nloc, unsigned& nx) {
    const unsigned G = gridDim.x * gridDim.y * gridDim.z;
    unsigned sum, cnt, mine, sp = 0u;
    for (;;) {
        sum = 0u; cnt = 0u; mine = 0u;
#pragma unroll
        for (unsigned j = 0; j < 16; ++j) { const unsigned c = xb_ld(&bar[XB_XCNT(j)]); sum += c; cnt += (c > 0u) ? 1u : 0u; mine = (j == x) ? c : mine; }
        if (sum == G) break;
        __builtin_amdgcn_s_sleep(1);
        if ((++sp & 255u) == 0u) { if (xb_ld(&bar[XB_TMO])) break; if (sp > XB_SPIN_CAP) { atomicAdd(&bar[XB_TMO], 1u); break; } }
    }
    nloc = mine > 0u ? mine : 1u; nx = cnt > 0u ? cnt : 1u;
}
__device__ __forceinline__ void xcd_barrier(const XcdBarrier& b) {
    asm volatile("s_waitcnt vmcnt(0)" ::: "memory");
    __syncthreads();
    if (threadIdx.x == 0) {
        unsigned* bar = b.bar;
        __builtin_amdgcn_s_waitcnt(0);
        unsigned nloc = b.st[0], nx = b.st[1];
        if (nloc == 0u) { xcd_barrier_complete(bar, b.x, nloc, nx); b.st[0] = nloc; b.st[1] = nx; }
        const unsigned old = xb_add(&bar[XB_XSUB(b.x)], 1u);
        const unsigned gen = old / nloc;
        if (old + 1u == (gen + 1u) * nloc) {
            __builtin_amdgcn_fence(__ATOMIC_RELEASE, "agent");
            asm volatile("s_waitcnt vmcnt(0)" ::: "memory");
            const unsigned og = xb_add(&bar[XB_TOP], 1u);
            const unsigned tg = og / nx;
            if (og + 1u == (tg + 1u) * nx) xb_add(&bar[XB_TOPGEN], 1u);
            else XB_SPIN(xb_ld(&bar[XB_TOPGEN]) == tg, bar);
            __builtin_amdgcn_fence(__ATOMIC_ACQUIRE, "agent");
            xb_add(&bar[XB_XGEN(b.x)], 1u);
            asm volatile("s_waitcnt vmcnt(0)" ::: "memory");
        } else {
            XB_SPIN(xb_ld(&bar[XB_XGEN(b.x)]) == gen, bar);
            __builtin_amdgcn_fence(__ATOMIC_ACQUIRE, "agent");
            asm volatile("s_waitcnt vmcnt(0)" ::: "memory");
        }
    }
    __syncthreads();
}

__device__ __forceinline__ unsigned cvtpk(float lo, float hi) { unsigned r; asm("v_cvt_pk_bf16_f32 %0, %1, %2" : "=v"(r) : "v"(lo), "v"(hi)); return r; }
__device__ __forceinline__ float bflo(unsigned u) { return __uint_as_float(u << 16); }
__device__ __forceinline__ float bfhi(unsigned u) { return __uint_as_float(u & 0xffff0000u); }
__device__ __forceinline__ float sigmoidf_(float x) { return __builtin_amdgcn_rcpf(1.f + __builtin_amdgcn_exp2f(-1.4426950408889634f * x)); }
__device__ __forceinline__ float gelu_tanh(float x) { const float u = 0.7978845608028654f * (x + 0.044715f * x * x * x); return x * __builtin_amdgcn_rcpf(1.f + __builtin_amdgcn_exp2f(-2.885390081777927f * u)); }
__device__ __forceinline__ float dot2bf(unsigned a, unsigned b, float c) { return __builtin_amdgcn_fdot2_f32_bf16(__builtin_bit_cast(bf16x2v, a), __builtin_bit_cast(bf16x2v, b), c, false); }
__device__ __forceinline__ unsigned pack4f8(float a, float b, float c, float d) { int x = __builtin_amdgcn_cvt_pk_fp8_f32(a, b, 0, false); x = __builtin_amdgcn_cvt_pk_fp8_f32(c, d, x, true); return (unsigned)x; }
__device__ __forceinline__ uint2 pack4(f32x4 v) { uint2 r; r.x = cvtpk(v[0], v[1]); r.y = cvtpk(v[2], v[3]); return r; }
__device__ __forceinline__ f32x4 unpack4(uint2 u) { f32x4 r; r[0] = bflo(u.x); r[1] = bfhi(u.x); r[2] = bflo(u.y); r[3] = bfhi(u.y); return r; }

__device__ __forceinline__ int otid() { int t = threadIdx.x; asm volatile("" : "+v"(t)); return t; }
#define PH_TID const int tid = otid(), lane = tid & 63, wave = tid >> 6; (void)lane; (void)wave;

struct Params {
    const float* in[34];
    float* out;
    unsigned char* ws;
    int ph_lo, ph_hi;
};

__device__ __forceinline__ const float* pin(int i) {
    const __attribute__((address_space(4))) char* kp = (const __attribute__((address_space(4))) char*)__builtin_amdgcn_kernarg_segment_ptr();
    asm volatile("" : "+s"(kp));
    return *(const float* const __attribute__((address_space(4)))*)(kp + i * 8);
}

constexpr int BK = 64, HALF = 128, HT = HALF * BK;
__device__ __forceinline__ int lds_byte(int r, int c) {
    int st = (r >> 4) * 2 + (c >> 5), rr = r & 15, cc = c & 31, ob = rr * 64 + cc * 2;
    return st * 1024 + (ob ^ (((ob >> 9) & 1) << 5));
}
__device__ __forceinline__ void stage_rc(int b, int& Rr, int& Cc) {
    int st = b / 1024, sb = b % 1024, swz = sb ^ (((sb >> 9) & 1) << 5);
    Rr = (st >> 1) * 16 + swz / 64; Cc = (st & 1) * 32 + (swz % 64) / 2;
}
typedef f32x4 Acc[2][2][4][2];
#define EPI_LOOP for (int ai = 0; ai < 2; ++ai) for (int bj = 0; bj < 2; ++bj) for (int m = 0; m < 4; ++m) for (int n = 0; n < 2; ++n)

template <int F8, class Epi>
__device__ __forceinline__ void gemm_tile_acc(const u16* __restrict__ Pm, int ldp, const u16* __restrict__ Qm, int ldq, int K, u16* shm, Acc& acc, Epi& epi) {
#define SA(b, h) (shm + ((b) * 2 + (h)) * HT)
#define SB(b, h) (shm + (4 + (b) * 2 + (h)) * HT)
#define STAGE_X(T, PP, BASE, LD, VOFF, br, kt) do { const char* _g = (const char*)(BASE) + ((size_t)(br) * (LD) + (size_t)(kt) * BK) * 2; \
      __builtin_amdgcn_global_load_lds((const unsigned*)(_g + (VOFF)), (unsigned*)((char*)(PP) + (T) * 16), 16, 0, 0); \
      __builtin_amdgcn_global_load_lds((const unsigned*)(_g + (size_t)(LD) * 128 + (VOFF)), (unsigned*)((char*)(PP) + (T) * 16 + 8192), 16, 0, 0); } while (0)
#define STAGE_A(PP, br, kt) STAGE_X(t0_, PP, Pm, ldp, voffA, br, kt)
#define STAGE_B(PP, br, kt) STAGE_X(t0_, PP, Qm, ldq, voffB, br, kt)
#define LDA(dst, b, h) for (int m = 0; m < 4; ++m) \
    dst[m] = __builtin_shufflevector(*reinterpret_cast<const v4i*>((char*)SA(b, h) + lds_byte(wr * 64 + m * 16 + fr, fq * 8)), \
                                     *reinterpret_cast<const v4i*>((char*)SA(b, h) + lds_byte(wr * 64 + m * 16 + fr, 32 + fq * 8)), 0, 1, 2, 3, 4, 5, 6, 7)
#define LDB(dst, b, h) for (int n = 0; n < 2; ++n) \
    dst[n] = __builtin_shufflevector(*reinterpret_cast<const v4i*>((char*)SB(b, h) + lds_byte(wc * 32 + n * 16 + fr, fq * 8)), \
                                     *reinterpret_cast<const v4i*>((char*)SB(b, h) + lds_byte(wc * 32 + n * 16 + fr, 32 + fq * 8)), 0, 1, 2, 3, 4, 5, 6, 7)
#define FLO(x) __builtin_bit_cast(bf16x8, __builtin_shufflevector(x, x, 0, 1, 2, 3))
#define FHI(x) __builtin_bit_cast(bf16x8, __builtin_shufflevector(x, x, 4, 5, 6, 7))
#define MMA(ai, bj, At, Bt) do { __builtin_amdgcn_s_setprio(1); \
    if (F8 == 1) { for (int m = 0; m < 4; ++m) for (int n = 0; n < 2; ++n) \
      asm("v_mfma_f32_16x16x128_f8f6f4 %0, %1, %2, %0" : "+v"(acc[ai][bj][m][n]) : "v"(At[m]), "v"(Bt[n])); } \
    else if (F8 == 2) { for (int m = 0; m < 4; ++m) for (int n = 0; n < 2; ++n) \
      asm("v_mfma_f32_16x16x128_f8f6f4 %0, %1, %2, %0 cbsz:4 blgp:4" : "+v"(acc[ai][bj][m][n]) : "v"(__builtin_shufflevector(At[m], At[m], 0, 1, 2, 3)), "v"(__builtin_shufflevector(Bt[n], Bt[n], 0, 1, 2, 3))); \
      for (int m = 0; m < 4; ++m) for (int n = 0; n < 2; ++n) \
      asm("v_mfma_f32_16x16x128_f8f6f4 %0, %1, %2, %0 cbsz:4 blgp:4" : "+v"(acc[ai][bj][m][n]) : "v"(__builtin_shufflevector(At[m], At[m], 4, 5, 6, 7)), "v"(__builtin_shufflevector(Bt[n], Bt[n], 4, 5, 6, 7))); } \
    else { for (int m = 0; m < 4; ++m) for (int n = 0; n < 2; ++n) { \
      acc[ai][bj][m][n] = __builtin_amdgcn_mfma_f32_16x16x32_bf16(FLO(At[m]), FLO(Bt[n]), acc[ai][bj][m][n], 0, 0, 0); \
      acc[ai][bj][m][n] = __builtin_amdgcn_mfma_f32_16x16x32_bf16(FHI(At[m]), FHI(Bt[n]), acc[ai][bj][m][n], 0, 0, 0); } } \
    __builtin_amdgcn_s_setprio(0); } while (0)
#define WAIT_V(n) asm volatile("s_waitcnt vmcnt(" #n ")" ::: "memory")
#define WAIT_L(n) asm volatile("s_waitcnt lgkmcnt(" #n ")" ::: "memory")
#define BAR __builtin_amdgcn_s_barrier()
#define SCHED __builtin_amdgcn_sched_barrier(0)
    const int t0_ = otid();
    int wid = t0_ >> 6, lane = t0_ & 63, wr = wid >> 2, wc = wid & 3, fr = lane & 15, fq = lane >> 4;
    unsigned voffA, voffB;
    { int _r, _c; stage_rc(t0_ * 16, _r, _c); voffA = (unsigned)(_r * ldp + _c) * 2u; voffB = (unsigned)(_r * ldq + _c) * 2u; }
    v8i At[4], B0[2], B1[2];
    const int nt = K / BK;
    STAGE_B(SB(0, 0), 0, 0); STAGE_A(SA(0, 0), 0, 0);
    STAGE_B(SB(0, 1), HALF, 0); STAGE_A(SA(0, 1), HALF, 0);
    if (wr == 1) BAR;
    WAIT_V(4); BAR;
    STAGE_B(SB(1, 0), 0, 1); STAGE_A(SA(1, 0), 0, 1); STAGE_B(SB(1, 1), HALF, 1);
    WAIT_V(6); BAR;
    for (int t = 0; t < nt - 2; t += 2) {
        LDB(B0, 0, 0); SCHED; LDA(At, 0, 0); STAGE_A(SA(1, 1), HALF, t + 1);
        WAIT_L(8); BAR; WAIT_L(0); MMA(0, 0, At, B0); BAR; SCHED;
        LDB(B1, 0, 1); STAGE_B(SB(0, 0), 0, t + 2);
        BAR; WAIT_L(0); MMA(0, 1, At, B1); BAR;
        LDA(At, 0, 1); STAGE_A(SA(0, 0), 0, t + 2);
        BAR; WAIT_L(0); MMA(1, 0, At, B0); BAR; SCHED;
        STAGE_B(SB(0, 1), HALF, t + 2);
        WAIT_V(6); BAR; MMA(1, 1, At, B1); BAR;
        LDB(B0, 1, 0); SCHED; LDA(At, 1, 0); STAGE_A(SA(0, 1), HALF, t + 2);
        WAIT_L(8); BAR; WAIT_L(0); MMA(0, 0, At, B0); BAR; SCHED;
        LDB(B1, 1, 1); STAGE_B(SB(1, 0), 0, t + 3);
        BAR; WAIT_L(0); MMA(0, 1, At, B1); BAR;
        LDA(At, 1, 1); STAGE_A(SA(1, 0), 0, t + 3);
        BAR; WAIT_L(0); MMA(1, 0, At, B0); BAR; SCHED;
        STAGE_B(SB(1, 1), HALF, t + 3);
        WAIT_V(6); BAR; MMA(1, 1, At, B1); BAR;
    }
    int tz = threadIdx.x; asm volatile("" : "+v"(tz)); wid = tz >> 6; lane = tz & 63; wr = wid >> 2; wc = wid & 3; fr = lane & 15; fq = lane >> 4;
    { int _r, _c; stage_rc(tz * 16, _r, _c); voffA = (unsigned)(_r * ldp + _c) * 2u; }
    { LDB(B0, 0, 0); WAIT_V(0); LDA(At, 0, 0); STAGE_X(tz, SA(1, 1), Pm, ldp, voffA, HALF, nt - 1);
      BAR; WAIT_L(0); MMA(0, 0, At, B0); BAR;
      LDB(B1, 0, 1); BAR; WAIT_L(0); MMA(0, 1, At, B1); BAR;
      LDA(At, 0, 1); WAIT_V(4); BAR; WAIT_L(0); MMA(1, 0, At, B0); MMA(1, 1, At, B1); BAR; }
    { LDB(B0, 1, 0); LDA(At, 1, 0); WAIT_V(2); BAR; WAIT_L(0); MMA(0, 0, At, B0); BAR;
      LDB(B1, 1, 1); WAIT_V(0); BAR; WAIT_L(0); MMA(0, 1, At, B1); BAR;
      LDA(At, 1, 1); BAR; WAIT_L(0); MMA(1, 0, At, B0); MMA(1, 1, At, B1); BAR; }
    if (wr == 0) BAR;
    if (F8) asm volatile("s_nop 7\n\ts_nop 7\n\ts_nop 7" ::: "memory");
    epi(acc, wr, wc, fr, fq);
    __syncthreads();
#undef SA
#undef SB
#undef STAGE_X
#undef STAGE_A
#undef STAGE_B
#undef LDA
#undef LDB
#undef MMA
#undef FLO
#undef FHI
}
template <int F8, class Epi>
__device__ __forceinline__ void gemm_tile(const u16* __restrict__ Pm, int ldp, const u16* __restrict__ Qm, int ldq, int K, u16* shm, Epi& epi) {
    Acc acc = {}; gemm_tile_acc<F8>(Pm, ldp, Qm, ldq, K, shm, acc, epi);
}
#define EPI_LOFF(ld, es) ((unsigned)(((wc * 32 + fr) * (ld) + wr * 64 + fq * 4) * (es)))
#define EPI_UOFF(ld, es) ((size_t)(((bj * 128 + n * 16) * (ld) + ai * 128 + m * 16) * (es)))
#define EPI_ILOFF(es) ((unsigned)((wr * 64 + fq * 4) * (es)))
#define EPI_IUOFF(es) ((size_t)((ai * 128 + m * 16) * (es)))
#define TR4(p0, p1, p2, p3) do { \
        { const auto x_ = __builtin_amdgcn_permlane32_swap(p0, p2, false, false); p0 = x_[0]; p2 = x_[1]; } \
        { const auto x_ = __builtin_amdgcn_permlane32_swap(p1, p3, false, false); p1 = x_[0]; p3 = x_[1]; } \
        { const auto x_ = __builtin_amdgcn_permlane16_swap(p0, p1, false, false); p0 = x_[0]; p1 = x_[1]; } \
        { const auto x_ = __builtin_amdgcn_permlane16_swap(p2, p3, false, false); p2 = x_[0]; p3 = x_[1]; } } while (0)
#define EPI_LOOP3 for (int ai = 0; ai < 2; ++ai) for (int bj = 0; bj < 2; ++bj) for (int n = 0; n < 2; ++n)
#define EPI_UOFF3(ld, es) ((size_t)(((bj * 128 + n * 16) * (ld) + ai * 128) * (es)))
#define EPI_LOFF16(ld, es) ((unsigned)(((wc * 32 + fr) * (ld) + wr * 64 + fq * 16) * (es)))
#define ST16x2(ptr, q0, q1, q2, q3) do { unsigned l0_ = (q0).x, l1_ = (q1).x, l2_ = (q2).x, l3_ = (q3).x, h0_ = (q0).y, h1_ = (q1).y, h2_ = (q2).y, h3_ = (q3).y; \
        TR4(l0_, l1_, l2_, l3_); TR4(h0_, h1_, h2_, h3_); \
        *(u32x4*)(ptr) = (u32x4){l0_, h0_, l1_, h1_}; *(u32x4*)((char*)(ptr) + 16) = (u32x4){l2_, h2_, l3_, h3_}; } while (0)
#define LD16x2(ptr, q0, q1, q2, q3) do { const u32x4 A_ = *(const u32x4*)(ptr), B_ = *(const u32x4*)((const char*)(ptr) + 16); \
        unsigned l0_ = A_[0], h0_ = A_[1], l1_ = A_[2], h1_ = A_[3], l2_ = B_[0], h2_ = B_[1], l3_ = B_[2], h3_ = B_[3]; \
        TR4(l0_, l1_, l2_, l3_); TR4(h0_, h1_, h2_, h3_); \
        (q0).x = l0_; (q0).y = h0_; (q1).x = l1_; (q1).y = h1_; (q2).x = l2_; (q2).y = h2_; (q3).x = l3_; (q3).y = h3_; } while (0)

struct EpiG1 {
    int kind;
    void* out; int ldo;
    bool lat; int t0;
    const float2* rope; float qscale; float wsc;
    __device__ __forceinline__ void operator()(Acc& acc, int wr, int wc, int fr, int fq) {
        const bool f8 = (kind != 0);
        const unsigned loff = f8 ? EPI_LOFF(ldo, 1) : EPI_LOFF(ldo, 2);
#pragma unroll
        for (int bj = 0; bj < 2; ++bj)
#pragma unroll
        for (int n = 0; n < 2; ++n) {
            const int j = bj * 128 + wc * 32 + n * 16 + fr;
            const int t = t0 + j, pr = t >> 6, pc = t & 63;
#pragma unroll
            for (int ai = 0; ai < 2; ++ai) {
                f32x4 v0 = acc[ai][bj][0][n] * wsc, v1 = acc[ai][bj][1][n] * wsc, v2 = acc[ai][bj][2][n] * wsc, v3 = acc[ai][bj][3][n] * wsc;
                if ((kind == 1 || kind == 2) && lat) {
#pragma unroll
                    for (int e = 0; e < 4; ++e) {
                        const float2 cr = rope[pr * 16 + fq * 4 + e], cc = rope[pc * 16 + fq * 4 + e];
                        const float a1 = v0[e], a2 = v1[e], b1 = v2[e], b2 = v3[e];
                        v0[e] = a1 * cr.x - a2 * cr.y; v1[e] = a1 * cr.y + a2 * cr.x;
                        v2[e] = b1 * cc.x - b2 * cc.y; v3[e] = b1 * cc.y + b2 * cc.x;
                    }
                }
                if (kind == 3) {
                    const float c1 = -1.4426950408889634f * wsc, c0 = 0.0078125f;
#pragma unroll
                    for (int e = 0; e < 4; ++e) {
                        v0[e] = __builtin_amdgcn_rcpf(c0 + __builtin_amdgcn_exp2f(__builtin_fmaf(acc[ai][bj][0][n][e], c1, -7.f)));
                        v1[e] = __builtin_amdgcn_rcpf(c0 + __builtin_amdgcn_exp2f(__builtin_fmaf(acc[ai][bj][1][n][e], c1, -7.f)));
                        v2[e] = __builtin_amdgcn_rcpf(c0 + __builtin_amdgcn_exp2f(__builtin_fmaf(acc[ai][bj][2][n][e], c1, -7.f)));
                        v3[e] = __builtin_amdgcn_rcpf(c0 + __builtin_amdgcn_exp2f(__builtin_fmaf(acc[ai][bj][3][n][e], c1, -7.f)));
                    }
                }
                if (f8) {
                    if (kind != 3) { v0 *= qscale; v1 *= qscale; v2 *= qscale; v3 *= qscale; }
                    unsigned p0 = pack4f8(v0[0], v0[1], v0[2], v0[3]), p1 = pack4f8(v1[0], v1[1], v1[2], v1[3]), p2 = pack4f8(v2[0], v2[1], v2[2], v2[3]), p3 = pack4f8(v3[0], v3[1], v3[2], v3[3]);
                    TR4(p0, p1, p2, p3);
                    char* o = (char*)out + (size_t)((bj * 128 + n * 16) * ldo + ai * 128) + loff + fq * 12;
                    *(u32x4*)o = (u32x4){p0, p1, p2, p3};
                } else {
                    char* o = (char*)out + (size_t)(((bj * 128 + n * 16) * ldo + ai * 128) * 2) + loff + fq * 24;
                    const uint2 q0 = pack4(v0), q1 = pack4(v1), q2 = pack4(v2), q3 = pack4(v3);
                    ST16x2(o, q0, q1, q2, q3);
                }
            }
        }
    }
};
struct EpiV {
    unsigned char* vt;
    __device__ __forceinline__ void operator()(Acc& acc, int wr, int wc, int fr, int fq) {
        const unsigned loff = EPI_LOFF16(SK, 1);
#pragma unroll
        EPI_LOOP3 { const f32x4 v0 = acc[ai][bj][0][n] * (1.f / 32.f), v1 = acc[ai][bj][1][n] * (1.f / 32.f), v2 = acc[ai][bj][2][n] * (1.f / 32.f), v3 = acc[ai][bj][3][n] * (1.f / 32.f);
            unsigned p0 = pack4f8(v0[0], v0[1], v0[2], v0[3]), p1 = pack4f8(v1[0], v1[1], v1[2], v1[3]), p2 = pack4f8(v2[0], v2[1], v2[2], v2[3]), p3 = pack4f8(v3[0], v3[1], v3[2], v3[3]);
            TR4(p0, p1, p2, p3);
            *(u32x4*)((char*)vt + EPI_UOFF3(SK, 1) + loff) = (u32x4){p0, p1, p2, p3}; }
    }
};
struct EpiStoreF8 {
    unsigned char* out; float sc;
    __device__ __forceinline__ void operator()(Acc& acc, int wr, int wc, int fr, int fq) {
        const unsigned loff = EPI_LOFF16(2048, 1);
#pragma unroll
        EPI_LOOP3 { const f32x4 v0 = acc[ai][bj][0][n] * sc, v1 = acc[ai][bj][1][n] * sc, v2 = acc[ai][bj][2][n] * sc, v3 = acc[ai][bj][3][n] * sc;
            unsigned p0 = pack4f8(v0[0], v0[1], v0[2], v0[3]), p1 = pack4f8(v1[0], v1[1], v1[2], v1[3]), p2 = pack4f8(v2[0], v2[1], v2[2], v2[3]), p3 = pack4f8(v3[0], v3[1], v3[2], v3[3]);
            TR4(p0, p1, p2, p3);
            *(u32x4*)((char*)out + EPI_UOFF3(2048, 1) + loff) = (u32x4){p0, p1, p2, p3}; }
    }
};
struct EpiPool {
    unsigned char* out; const float* scale;
    __device__ __forceinline__ void operator()(Acc& acc, int wr, int wc, int fr, int fq) {
        const unsigned loff = EPI_LOFF(512, 1), iloff = EPI_ILOFF(4);
#pragma unroll
        EPI_LOOP3 { unsigned pk[4];
#pragma unroll
            for (int m = 0; m < 4; ++m) { const f32x4 s = *(const f32x4*)((const char*)scale + EPI_IUOFF(4) + iloff); const f32x4 v = acc[ai][bj][m][n] * s * 4.f; pk[m] = pack4f8(v[0], v[1], v[2], v[3]); }
            unsigned p0 = pk[0], p1 = pk[1], p2 = pk[2], p3 = pk[3];
            TR4(p0, p1, p2, p3);
            *(u32x4*)((char*)out + EPI_UOFF3(512, 1) + loff + fq * 12) = (u32x4){p0, p1, p2, p3}; }
    }
};
struct EpiS5E {
    float* out;
    __device__ __forceinline__ void operator()(Acc& acc, int wr, int wc, int fr, int fq) {
        const unsigned loff = EPI_LOFF(256, 4);
#pragma unroll
        EPI_LOOP { *(f32x4*)((char*)out + EPI_UOFF(256, 4) + loff) = acc[ai][bj][m][n]; }
    }
};
struct EpiS5Y {
    u16* yg; int g, it, nt;
    __device__ __forceinline__ void operator()(Acc& acc, int wr, int wc, int fr, int fq) {
        if (nt < 4) {
            const unsigned loff = (unsigned)(((((wc * 32 + fr) * S5L + wr * 4) * 512) + fq * 4) * 2);
#pragma unroll
            EPI_LOOP { f32x4 v = acc[ai][bj][m][n];
#pragma unroll
                for (int e = 0; e < 4; ++e) v[e] = gelu_tanh(v[e]);
                const size_t uo = ((size_t)((nt * 2 + bj) * SEQ + n * 16 * S5L + it * 16 + ai * 8 + m) * 512 + g * 16) * 2;
                *(uint2*)((char*)yg + uo + loff) = pack4(v); }
        } else {
            if (wc < 2) {
                const unsigned loff = (unsigned)(((((wc * 4 + (fr >> 3)) * CTXL + (fr & 7) * S5L + wr * 4) * 512) + fq * 4) * 2);
#pragma unroll
                for (int ai = 0; ai < 2; ++ai)
#pragma unroll
                for (int m = 0; m < 4; ++m)
#pragma unroll
                for (int n = 0; n < 2; ++n) { f32x4 v = acc[ai][0][m][n];
#pragma unroll
                    for (int e = 0; e < 4; ++e) v[e] = gelu_tanh(v[e]);
                    const size_t uo = ((size_t)(RL + n * 2 * CTXL + it * 16 + ai * 8 + m) * 512 + g * 16) * 2;
                    *(uint2*)((char*)yg + uo + loff) = pack4(v); }
            }
        }
    }
};
struct EpiGlu {
    unsigned char* out; const u16* yg;
    __device__ __forceinline__ void operator()(Acc& acc, int wr, int wc, int fr, int fq) {
        const unsigned loff = EPI_LOFF(512, 2), loff1 = EPI_LOFF(512, 1);
#pragma unroll
        EPI_LOOP3 { uint2 g4[4]; LD16x2((const char*)yg + EPI_UOFF3(512, 2) + loff + fq * 24, g4[0], g4[1], g4[2], g4[3]);
            unsigned pk[4];
#pragma unroll
            for (int m = 0; m < 4; ++m) { const f32x4 gg = unpack4(g4[m]); f32x4 v = acc[ai][bj][m][n];
#pragma unroll
                for (int e = 0; e < 4; ++e) v[e] = 4.f * gg[e] * sigmoidf_(v[e]);
                pk[m] = pack4f8(v[0], v[1], v[2], v[3]); }
            unsigned p0 = pk[0], p1 = pk[1], p2 = pk[2], p3 = pk[3];
            TR4(p0, p1, p2, p3);
            *(u32x4*)((char*)out + EPI_UOFF3(512, 1) + loff1 + fq * 12) = (u32x4){p0, p1, p2, p3}; }
    }
};
struct EpiMerge {
    unsigned char* mrg8; const unsigned char* gate; int br;
    __device__ __forceinline__ void operator()(Acc& acc, int wr, int wc, int fr, int fq) {
        const unsigned loffg = EPI_LOFF(6144, 1), loff8 = EPI_LOFF(2048, 1);
        const float GE = 0.0009765625f;
        const bool more = br < 2; const unsigned char* gnext = more ? gate + 2048 : gate;
#pragma unroll
        for (int ai = 0; ai < 2; ++ai) {
#pragma unroll
            for (int bj = 0; bj < 2; ++bj)
#pragma unroll
            for (int n = 0; n < 2; ++n) {
                const size_t uo = (size_t)((bj * 128 + n * 16) * 6144 + ai * 128);
                const u32x4 qa = *(const u32x4*)((const char*)gate + uo + loffg + fq * 12), qb = *(const u32x4*)((const char*)gnext + uo + loffg + fq * 12);
                unsigned a0 = qa[0], a1 = qa[1], a2 = qa[2], a3 = qa[3], b0 = qb[0], b1 = qb[1], b2 = qb[2], b3 = qb[3];
                TR4(a0, a1, a2, a3); TR4(b0, b1, b2, b3);
#pragma unroll
                for (int m = 0; m < 4; ++m) {
                    const int ga = (int)((m == 0) ? a0 : (m == 1) ? a1 : (m == 2) ? a2 : a3), gb = (int)((m == 0) ? b0 : (m == 1) ? b1 : (m == 2) ? b2 : b3);
                    const f32x2 a01 = __builtin_amdgcn_cvt_pk_f32_fp8(ga, false), a23 = __builtin_amdgcn_cvt_pk_f32_fp8(ga, true);
                    const f32x2 b01 = __builtin_amdgcn_cvt_pk_f32_fp8(gb, false), b23 = __builtin_amdgcn_cvt_pk_f32_fp8(gb, true);
                    const float r0 = more ? __builtin_amdgcn_rcpf(b01[0] + GE) : (4.f / (64.f * 128.f)), r1 = more ? __builtin_amdgcn_rcpf(b01[1] + GE) : (4.f / (64.f * 128.f));
                    const float r2 = more ? __builtin_amdgcn_rcpf(b23[0] + GE) : (4.f / (64.f * 128.f)), r3 = more ? __builtin_amdgcn_rcpf(b23[1] + GE) : (4.f / (64.f * 128.f));
                    acc[ai][bj][m][n] *= (f32x4){(a01[0] + GE) * r0, (a01[1] + GE) * r1, (a23[0] + GE) * r2, (a23[1] + GE) * r3}; }
            }
            __builtin_amdgcn_sched_barrier(0); }
        if (!more) {
#pragma unroll
            for (int ai = 0; ai < 2; ++ai)
#pragma unroll
            for (int bj = 0; bj < 2; ++bj)
#pragma unroll
            for (int n = 0; n < 2; ++n) {
                const f32x4 v0 = acc[ai][bj][0][n], v1 = acc[ai][bj][1][n], v2 = acc[ai][bj][2][n], v3 = acc[ai][bj][3][n];
                unsigned p0 = pack4f8(v0[0], v0[1], v0[2], v0[3]), p1 = pack4f8(v1[0], v1[1], v1[2], v1[3]), p2 = pack4f8(v2[0], v2[1], v2[2], v2[3]), p3 = pack4f8(v3[0], v3[1], v3[2], v3[3]);
                TR4(p0, p1, p2, p3);
                *(u32x4*)((char*)mrg8 + (size_t)((bj * 128 + n * 16) * 2048 + ai * 128) + loff8 + fq * 12) = (u32x4){p0, p1, p2, p3};
            }
        }
    }
};
struct EpiRes {
    const void* xin; void* xout; const float* gate; float sc; bool in16, out16;
    __device__ __forceinline__ void operator()(Acc& acc, int wr, int wc, int fr, int fq) {
        const unsigned loff4 = EPI_LOFF(2048, 4), loff2 = EPI_LOFF(2048, 2), iloff = EPI_ILOFF(4);
#pragma unroll
        EPI_LOOP3 { uint2 xi[4], yo[4];
            if (in16) LD16x2((const char*)xin + EPI_UOFF3(2048, 2) + loff2 + fq * 24, xi[0], xi[1], xi[2], xi[3]);
#pragma unroll
            for (int m = 0; m < 4; ++m) { const f32x4 gg = *(const f32x4*)((const char*)gate + EPI_IUOFF(4) + iloff);
                f32x4 x;
                if (in16) x = unpack4(xi[m]); else x = *(const f32x4*)((const char*)xin + EPI_UOFF(2048, 4) + loff4);
                const f32x4 y = x + gg * acc[ai][bj][m][n] * sc;
                if (out16) yo[m] = pack4(y); else *(f32x4*)((char*)xout + EPI_UOFF(2048, 4) + loff4) = y; }
            if (out16) ST16x2((char*)xout + EPI_UOFF3(2048, 2) + loff2 + fq * 24, yo[0], yo[1], yo[2], yo[3]); }
    }
};
struct EpiF16 {
    _Float16* out; float sc;
    __device__ __forceinline__ void operator()(Acc& acc, int wr, int wc, int fr, int fq) {
        const unsigned loff = EPI_LOFF(2048, 2);
#pragma unroll
        EPI_LOOP3 { uint2 pk[4];
#pragma unroll
            for (int m = 0; m < 4; ++m) { const f32x4 v = acc[ai][bj][m][n] * sc; const h16x2 lo = (h16x2){(_Float16)v[0], (_Float16)v[1]}, hi = (h16x2){(_Float16)v[2], (_Float16)v[3]};
                pk[m].x = __builtin_bit_cast(unsigned, lo); pk[m].y = __builtin_bit_cast(unsigned, hi); }
            ST16x2((char*)out + EPI_UOFF3(2048, 2) + loff + fq * 24, pk[0], pk[1], pk[2], pk[3]); }
    }
};

__device__ __forceinline__ void transpose_item(const float* src, long lds_, u16* dst, long ldd, int k0, int n0, u16* scr, int lane) {
#pragma unroll 4
    for (int it = 0; it < 16; ++it) {
        const int r = it * 4 + (lane >> 4), c = (lane & 15) * 4;
        const float4 v = *(const float4*)(src + (long)(k0 + r) * lds_ + n0 + c);
        scr[(c + 0) * 72 + r] = (u16)(cvtpk(v.x, 0.f) & 0xffff); scr[(c + 1) * 72 + r] = (u16)(cvtpk(v.y, 0.f) & 0xffff);
        scr[(c + 2) * 72 + r] = (u16)(cvtpk(v.z, 0.f) & 0xffff); scr[(c + 3) * 72 + r] = (u16)(cvtpk(v.w, 0.f) & 0xffff);
    }
    __builtin_amdgcn_s_waitcnt(0xc07f);
    __builtin_amdgcn_wave_barrier();
#pragma unroll 4
    for (int it = 0; it < 8; ++it) {
        const int id = it * 64 + lane, nn = id >> 3, ch = id & 7;
        const uint4 v = *(const uint4*)(scr + nn * 72 + ch * 8);
        *(uint4*)(dst + (long)(n0 + nn) * ldd + k0 + ch * 8) = v;
    }
    __builtin_amdgcn_s_waitcnt(0xc07f);
    __builtin_amdgcn_wave_barrier();
}

__device__ __forceinline__ void transpose_item4(const float* src, long lds_, unsigned char* dst4, long ldd, int k0, int n0, unsigned char* scr, int lane, float scale) {
#pragma unroll 4
    for (int it = 0; it < 8; ++it) {
        const int r2 = it * 4 + (lane >> 4), c = (lane & 15) * 4;
        const float4 v0 = *(const float4*)(src + (long)(k0 + 2 * r2) * lds_ + n0 + c), v1 = *(const float4*)(src + (long)(k0 + 2 * r2 + 1) * lds_ + n0 + c);
        unsigned b = 0u;
        b = __builtin_amdgcn_cvt_scalef32_pk_fp4_f32(b, v0.x * scale, v1.x * scale, 1.0f, 0); b = __builtin_amdgcn_cvt_scalef32_pk_fp4_f32(b, v0.y * scale, v1.y * scale, 1.0f, 1);
        b = __builtin_amdgcn_cvt_scalef32_pk_fp4_f32(b, v0.z * scale, v1.z * scale, 1.0f, 2); b = __builtin_amdgcn_cvt_scalef32_pk_fp4_f32(b, v0.w * scale, v1.w * scale, 1.0f, 3);
        scr[(c + 0) * 48 + r2] = (unsigned char)(b & 0xff); scr[(c + 1) * 48 + r2] = (unsigned char)((b >> 8) & 0xff);
        scr[(c + 2) * 48 + r2] = (unsigned char)((b >> 16) & 0xff); scr[(c + 3) * 48 + r2] = (unsigned char)(b >> 24);
    }
    __builtin_amdgcn_s_waitcnt(0xc07f);
    __builtin_amdgcn_wave_barrier();
#pragma unroll
    for (int it = 0; it < 2; ++it) {
        const int id = it * 64 + lane, nn = id >> 1, ch = id & 1;
        const uint4 v = *(const uint4*)(scr + nn * 48 + ch * 16);
        *(uint4*)(dst4 + (long)(n0 + nn) * ldd + k0 / 2 + ch * 16) = v;
    }
    __builtin_amdgcn_s_waitcnt(0xc07f);
    __builtin_amdgcn_wave_barrier();
}
__device__ __forceinline__ void transpose_item8(const float* src, long lds_, unsigned char* dst, long ldd, int k0, int n0, unsigned char* scr, int lane, float scale) {
#pragma unroll 4
    for (int it = 0; it < 16; ++it) {
        const int r = it * 4 + (lane >> 4), c = (lane & 15) * 4;
        const float4 v = *(const float4*)(src + (long)(k0 + r) * lds_ + n0 + c);
        const unsigned pk = pack4f8(v.x * scale, v.y * scale, v.z * scale, v.w * scale);
        scr[(c + 0) * 80 + r] = (unsigned char)(pk & 0xff); scr[(c + 1) * 80 + r] = (unsigned char)((pk >> 8) & 0xff);
        scr[(c + 2) * 80 + r] = (unsigned char)((pk >> 16) & 0xff); scr[(c + 3) * 80 + r] = (unsigned char)(pk >> 24);
    }
    __builtin_amdgcn_s_waitcnt(0xc07f);
    __builtin_amdgcn_wave_barrier();
#pragma unroll
    for (int it = 0; it < 4; ++it) {
        const int id = it * 64 + lane, nn = id >> 2, ch = id & 3;
        const uint4 v = *(const uint4*)(scr + nn * 80 + ch * 16);
        *(uint4*)(dst + (long)(n0 + nn) * ldd + k0 + ch * 16) = v;
    }
    __builtin_amdgcn_s_waitcnt(0xc07f);
    __builtin_amdgcn_wave_barrier();
}

template <bool F8, bool IN16 = false>
__device__ __forceinline__ void rms_mod_row(const void* xr, const float* g, const float* shift, const float* scale, void* o, int lane, unsigned* o4 = nullptr, unsigned char* o8 = nullptr) {
    float4 v[8]; float ss = 0.f;
#pragma unroll
    for (int i = 0; i < 4; ++i) {
        if (IN16) { const u32x4 t = ((const u32x4*)xr)[lane + 64 * i]; const unsigned t0 = t[0], t1 = t[1], t2 = t[2], t3 = t[3];
            v[2 * i] = make_float4(bflo(t0), bfhi(t0), bflo(t1), bfhi(t1)); v[2 * i + 1] = make_float4(bflo(t2), bfhi(t2), bflo(t3), bfhi(t3)); }
        else { v[2 * i] = ((const float4*)xr)[(lane + 64 * i) * 2]; v[2 * i + 1] = ((const float4*)xr)[(lane + 64 * i) * 2 + 1]; }
    }
#pragma unroll
    for (int i = 0; i < 8; ++i) ss += v[i].x * v[i].x + v[i].y * v[i].y + v[i].z * v[i].z + v[i].w * v[i].w;
#pragma unroll
    for (int of = 32; of > 0; of >>= 1) ss += __shfl_xor(ss, of);
    const float inv = rsqrtf(ss * (1.f / 2048.f) + 1e-6f);
#pragma unroll
    for (int i = 0; i < 4; ++i) {
        unsigned pk[4], p8[2] = {0u, 0u};
#pragma unroll
        for (int h = 0; h < 2; ++h) {
            const int vi = (lane + 64 * i) * 2 + h;
            const float4 gg = ((const float4*)g)[vi], sh = ((const float4*)shift)[vi], sc = ((const float4*)scale)[vi]; const float4 x = v[2 * i + h];
            const float y0 = x.x * inv * gg.x * (1.f + sc.x) + sh.x, y1 = x.y * inv * gg.y * (1.f + sc.y) + sh.y;
            const float y2 = x.z * inv * gg.z * (1.f + sc.z) + sh.z, y3 = x.w * inv * gg.w * (1.f + sc.w) + sh.w;
            if (F8) { pk[h] = pack4f8(y0, y1, y2, y3);
                if (h == 0) { pk[2] = __builtin_amdgcn_cvt_scalef32_pk_fp4_f32(0u, y0 * G4_HS, y1 * G4_HS, 1.0f, 0); pk[2] = __builtin_amdgcn_cvt_scalef32_pk_fp4_f32(pk[2], y2 * G4_HS, y3 * G4_HS, 1.0f, 1); }
                else { pk[2] = __builtin_amdgcn_cvt_scalef32_pk_fp4_f32(pk[2], y0 * G4_HS, y1 * G4_HS, 1.0f, 2); pk[2] = __builtin_amdgcn_cvt_scalef32_pk_fp4_f32(pk[2], y2 * G4_HS, y3 * G4_HS, 1.0f, 3); } }
            else { pk[2 * h] = cvtpk(y0, y1); pk[2 * h + 1] = cvtpk(y2, y3); if (o8) p8[h] = pack4f8(y0, y1, y2, y3); }
        }
        if (!F8 && o8) { uint2 q2; q2.x = p8[0]; q2.y = p8[1]; ((uint2*)o8)[lane + 64 * i] = q2; }
        if (F8 && o4) o4[lane + 64 * i] = pk[2];
        if (F8) { uint2 p2; p2.x = pk[0]; p2.y = pk[1]; ((uint2*)o)[lane + 64 * i] = p2; }
        else ((u32x4*)o)[lane + 64 * i] = (u32x4){pk[0], pk[1], pk[2], pk[3]};
    }
}

__device__ __forceinline__ void s5_lampow(float ar, float ai, float dt, float n, float& re, float& im) {
    const float mag = expf(ar * dt * n); float s, c; sincosf(ai * dt * n, &s, &c); re = mag * c; im = mag * s;
}
__device__ __forceinline__ void s5_coef(float ar, float ai, float dt, float& cre, float& cim) {
    float lr, li; s5_lampow(ar, ai, dt, 1.f, lr, li);
    const float den = ar * ar + ai * ai;
    cre = ((lr - 1.f) * ar + li * ai) / den; cim = (li * ar - (lr - 1.f) * ai) / den;
}

constexpr int AROW = 144, AKBUF = 128 * AROW, AVBUF = 144 * AROW;
__device__ __forceinline__ void attn_prep(char* shm) {
    const int tid = otid();
    for (int i = tid; i < 2 * 16 * 36; i += 512) { const int bufi = i / 576, r = (i % 576) / 36, c = i % 36;
        *(unsigned*)(shm + 2 * AKBUF + bufi * AVBUF + (128 + r) * AROW + c * 4) = (r == 0) ? 0x38383838u : 0u; }
    __syncthreads();
}
__device__ __forceinline__ void attn_unit(const unsigned char* __restrict__ Q8, const unsigned char* __restrict__ K8, const unsigned char* __restrict__ Vt8, unsigned char* __restrict__ Yatt,
                                          int b, int hd, int qrow0, int kt_lo, int kt_hi, float lam, float post_scale, const float* __restrict__ subg, char* shm) {
    const int tid = otid(), wave = tid >> 6, lane = tid & 63, q = lane & 15, g4 = lane >> 4;
    char* kbuf = shm; char* vbuf = shm + 2 * AKBUF;
    const unsigned char* qp = Q8 + (long)(qrow0 + wave * 16 + q) * 1024 + hd * 128;
    long qf[2][2];
#pragma unroll
    for (int c = 0; c < 2; ++c)
#pragma unroll
        for (int ks = 0; ks < 2; ++ks) qf[c][ks] = *(const long*)(qp + c * 64 + ks * 32 + g4 * 8);
    f32x4 O[2][8], OL[2];
#pragma unroll
    for (int c = 0; c < 2; ++c) { OL[c] = (f32x4){0.f, 0.f, 0.f, 0.f};
#pragma unroll
        for (int db = 0; db < 8; ++db) O[c][db] = (f32x4){0.f, 0.f, 0.f, 0.f}; }
    float mrun0 = 0.f, mrun1 = 0.f;
    const unsigned char* vtb = Vt8 + ((long)(b * 8 + hd) * 128) * SK;
    const int sr0 = tid >> 3, sc0 = tid & 7;
    const int kp0 = 16 * ((sr0 >> 2) & 7) + 4 * (sr0 >> 5) + (sr0 & 3);
    const int vsw0 = sc0 ^ (2 * (((sr0 >> 2) ^ (sr0 >> 3)) & 1));
    u32x4 kreg0, kreg1, vreg0, vreg1;
#define ATT_LOAD(kt) do { const long krow = ((kt) < 32) ? ((long)b * SEQ + (kt) * 128) : ((long)RL + b * CTXL + ((kt) - 32) * 128); \
        kreg0 = *(const u32x4*)(K8 + (krow + sr0) * 1024 + hd * 128 + sc0 * 16); kreg1 = *(const u32x4*)(K8 + (krow + sr0 + 64) * 1024 + hd * 128 + sc0 * 16); \
        vreg0 = *(const u32x4*)(vtb + (long)sr0 * SK + (kt) * 128 + sc0 * 16); vreg1 = *(const u32x4*)(vtb + (long)(sr0 + 64) * SK + (kt) * 128 + sc0 * 16); } while (0)
#define ATT_STORE(bufi) do { *(u32x4*)(kbuf + (bufi) * AKBUF + kp0 * AROW + sc0 * 16) = kreg0; *(u32x4*)(kbuf + (bufi) * AKBUF + (kp0 + 8) * AROW + sc0 * 16) = kreg1; \
        *(u32x4*)(vbuf + (bufi) * AVBUF + sr0 * AROW + vsw0 * 16) = vreg0; *(u32x4*)(vbuf + (bufi) * AVBUF + (sr0 + 64) * AROW + vsw0 * 16) = vreg1; } while (0)
    ATT_LOAD(kt_lo); ATT_STORE(0);
    __syncthreads();
    int cur = 0;
    for (int kt = kt_lo; kt < kt_hi; ++kt) {
        const bool more = (kt + 1 < kt_hi), first = (kt == kt_lo);
        if (more) ATT_LOAD(kt + 1);
        __builtin_amdgcn_sched_barrier(0);
        const char* Kc = kbuf + cur * AKBUF; const char* Vc = vbuf + cur * AVBUF;
        v8i pf[2];
#pragma unroll
        for (int c = 0; c < 2; ++c) {
            float mr = c ? mrun1 : mrun0;
            f32x4 st[8];
#pragma unroll
            for (int mb = 0; mb < 8; ++mb) st[mb] = (f32x4){-mr, -mr, -mr, -mr};
            __builtin_amdgcn_s_setprio(1);
#pragma unroll
            for (int ks = 0; ks < 2; ++ks)
#pragma unroll
                for (int mb = 0; mb < 8; ++mb) {
                    const long kf = *(const long*)(Kc + (16 * mb + q) * AROW + c * 64 + ks * 32 + g4 * 8);
                    st[mb] = __builtin_amdgcn_mfma_f32_16x16x32_fp8_fp8(kf, qf[c][ks], st[mb], 0, 0, 0);
                }
            __builtin_amdgcn_s_setprio(0);
            float tmax, tm2;
            asm volatile("s_nop 7\n\ts_nop 7" : "+v"(st[0]), "+v"(st[1]), "+v"(st[2]), "+v"(st[3]), "+v"(st[4]), "+v"(st[5]), "+v"(st[6]), "+v"(st[7]));
            asm("v_max3_f32 %0, %1, %2, %3" : "=v"(tmax) : "v"(st[0][0]), "v"(st[0][1]), "v"(st[0][2]));
            asm("v_max3_f32 %0, %1, %2, %3" : "=v"(tm2) : "v"(st[0][3]), "v"(st[1][0]), "v"(st[1][1]));
#pragma unroll
            for (int mb = 1; mb < 8; ++mb) {
                if (mb > 1) { asm("v_max3_f32 %0, %1, %2, %3" : "+v"(tmax) : "v"(st[mb][0]), "v"(st[mb][1]), "v"(tmax)); }
                asm("v_max3_f32 %0, %1, %2, %3" : "+v"(tm2) : "v"(st[mb][2]), "v"(st[mb][3]), "v"(tm2));
            }
            asm("v_max3_f32 %0, %1, %2, %3" : "+v"(tmax) : "v"(st[1][0]), "v"(st[1][1]), "v"(tmax));
            asm("v_max3_f32 %0, %1, %2, %3" : "+v"(tmax) : "v"(tm2), "v"(tm2), "v"(tmax));
            { const auto r16 = __builtin_amdgcn_permlane16_swap(__float_as_uint(tmax), __float_as_uint(tmax), false, false); tmax = fmaxf(__uint_as_float(r16[0]), __uint_as_float(r16[1])); }
            { const auto r32 = __builtin_amdgcn_permlane32_swap(__float_as_uint(tmax), __float_as_uint(tmax), false, false); tmax = fmaxf(__uint_as_float(r32[0]), __uint_as_float(r32[1])); }
            if (first || __any(tmax > 8.f)) {
                asm volatile("" ::: "memory");
                const float delta = (first || tmax > 8.f) ? tmax - 6.f : 0.f;
                const float alpha = __builtin_amdgcn_exp2f(-delta);
                mr += delta;
#pragma unroll
                for (int mb = 0; mb < 8; ++mb) st[mb] -= delta;
#pragma unroll
                for (int db = 0; db < 8; ++db) O[c][db] *= alpha;
                OL[c] *= alpha;
            }
            if (c) mrun1 = mr; else mrun0 = mr;
            v8i pk;
#pragma unroll
            for (int mb = 0; mb < 8; ++mb)
                pk[mb] = (int)pack4f8(__builtin_amdgcn_exp2f(st[mb][0]), __builtin_amdgcn_exp2f(st[mb][1]), __builtin_amdgcn_exp2f(st[mb][2]), __builtin_amdgcn_exp2f(st[mb][3]));
            pf[c] = pk;
        }
        asm volatile("s_nop 1" : "+v"(pf[0]), "+v"(pf[1]));
        __builtin_amdgcn_s_setprio(1);
        {
            const int vsx = (g4 ^ (((q >> 2) ^ (q >> 3)) & 1)) * 32;
            const char* vr0 = Vc + q * AROW + vsx;
            v8i vfa = __builtin_shufflevector(*(const v4i*)(vr0), *(const v4i*)(vr0 + 16), 0, 1, 2, 3, 4, 5, 6, 7), vfb;
#pragma unroll
            for (int db = 0; db < 9; ++db) {
                if (db < 8) { const char* vr = Vc + ((db + 1) * 16 + q) * AROW + vsx;
                    vfb = __builtin_shufflevector(*(const v4i*)(vr), *(const v4i*)(vr + 16), 0, 1, 2, 3, 4, 5, 6, 7); }
                if (db < 8) {
                    asm("v_mfma_f32_16x16x128_f8f6f4 %0, %1, %2, %0" : "+v"(O[0][db]) : "v"(vfa), "v"(pf[0]));
                    asm("v_mfma_f32_16x16x128_f8f6f4 %0, %1, %2, %0" : "+v"(O[1][db]) : "v"(vfa), "v"(pf[1]));
                } else {
                    asm("v_mfma_f32_16x16x128_f8f6f4 %0, %1, %2, %0" : "+v"(OL[0]) : "v"(vfa), "v"(pf[0]));
                    asm("v_mfma_f32_16x16x128_f8f6f4 %0, %1, %2, %0" : "+v"(OL[1]) : "v"(vfa), "v"(pf[1]));
                }
                vfa = vfb;
            }
        }
        __builtin_amdgcn_s_setprio(0);
        if (more) ATT_STORE(cur ^ 1);
        __syncthreads();
        cur ^= 1;
    }
#undef ATT_LOAD
#undef ATT_STORE
    asm volatile("s_nop 7\n\ts_nop 7\n\ts_nop 7" : "+v"(O[0][0]), "+v"(O[0][1]), "+v"(O[0][2]), "+v"(O[0][3]), "+v"(O[0][4]), "+v"(O[0][5]), "+v"(O[0][6]), "+v"(O[0][7]),
                 "+v"(O[1][0]), "+v"(O[1][1]), "+v"(O[1][2]), "+v"(O[1][3]), "+v"(O[1][4]), "+v"(O[1][5]), "+v"(O[1][6]), "+v"(O[1][7]), "+v"(OL[0]), "+v"(OL[1]));
    const float l0 = __shfl(OL[0][0], q), l1 = __shfl(OL[1][0], q);
    const float i0 = 1.f / l0, i1 = lam / l1;
    float ss = 0.f;
#pragma unroll
    for (int db = 0; db < 8; ++db)
#pragma unroll
        for (int e = 0; e < 4; ++e) { const float o = O[0][db][e] * i0 - O[1][db][e] * i1; O[0][db][e] = o; ss += o * o; }
    ss += __shfl_xor(ss, 16); ss += __shfl_xor(ss, 32);
    const float rs = rsqrtf(ss * (1.f / 128.f) + 1e-6f) * post_scale * 4.f;
    unsigned char* yo = Yatt + (long)(qrow0 + wave * 16 + q) * 1024 + hd * 128;
#pragma unroll
    for (int db = 0; db < 8; ++db) {
        const int dv = db * 16 + g4 * 4; const f32x4 gg = *(const f32x4*)(subg + dv);
        const f32x4 ov = O[0][db] * gg * rs; *(unsigned*)(yo + dv) = pack4f8(ov[0], ov[1], ov[2], ov[3]);
    }
}

__device__ __forceinline__ unsigned fenc(float f) { const unsigned u = __float_as_uint(f); return u ^ ((unsigned)((int)u >> 31) | 0x80000000u); }
__device__ __forceinline__ float fdec(unsigned k) { return __uint_as_float(k ^ (~(unsigned)((int)k >> 31) | 0x80000000u)); }
#define INS32(L, x) do { unsigned _x = (x); _Pragma("unroll") for (int _i = 0; _i < 16; ++_i) { const unsigned _h = max(L[_i], _x); _x = min(L[_i], _x); L[_i] = _h; } } while (0)
#define INS64(L, x) do { unsigned long long _x = (x); _Pragma("unroll") for (int _i = 0; _i < 16; ++_i) { const unsigned long long _a = L[_i]; const bool _g = _a > _x; L[_i] = _g ? _a : _x; _x = _g ? _x : _a; } } while (0)
#define CSWAP_D(a, b) do { const unsigned _h = max(a, b), _l = min(a, b); a = _h; b = _l; } while (0)
__device__ __forceinline__ void sort16_desc(unsigned (&v)[16]) {
#pragma unroll
    for (int k = 2; k <= 16; k <<= 1)
#pragma unroll
        for (int j = k >> 1; j > 0; j >>= 1)
#pragma unroll
            for (int i = 0; i < 16; ++i) { const int l = i ^ j; if (l > i) { if ((i & k) == 0) CSWAP_D(v[i], v[l]); else CSWAP_D(v[l], v[i]); } }
}
__device__ __forceinline__ void merge16_desc(unsigned (&L)[16], const unsigned (&B)[16]) {
#pragma unroll
    for (int i = 0; i < 16; ++i) L[i] = max(L[i], B[15 - i]);
#pragma unroll
    for (int j = 8; j > 0; j >>= 1)
#pragma unroll
        for (int i = 0; i < 16; ++i) if ((i & j) == 0) CSWAP_D(L[i], L[i + j]);
}

__global__ void __launch_bounds__(512, 2) fwd_kernel(Params p) {
    extern __shared__ __attribute__((aligned(16))) unsigned char lds[];
    const int G = gridDim.x, bx = blockIdx.x;
    const int vb = (G % 8 == 0) ? (bx % 8) * (G / 8) + bx / 8 : bx;
    const int lo = p.ph_lo, hi = p.ph_hi;
    unsigned char* ws = p.ws;
    XcdBarrier bar; bar.bar = (unsigned*)(ws + WS_CTL); bar.x = 0; bar.st = nullptr;
    if (hi - lo > 1) {
        if (threadIdx.x == 0) *(uint4*)(lds + BAR_LDS_OFF) = make_uint4(0u, 0u, 0u, 0u);
        __syncthreads();
        bar = xcd_barrier_post((unsigned*)(ws + WS_CTL), (volatile LAS unsigned*)(lds + BAR_LDS_OFF));
    }
#define PH_IN(k) (lo <= (k) && (k) < hi)
#define PH_SEAM(k) do { if ((k) + 1 < hi) xcd_barrier(bar); } while (0)
    u16* shm16 = (u16*)lds;
    float* MODS = (float*)(ws + WS_MODS);
    float2* ROPE = (float2*)(ws + WS_ROPE);
    float* XC = (float*)(ws + WS_XC);
    u16* XB = (u16*)(ws + WS_XB);
    u16* Hb = (u16*)(ws + WS_H);
    u16* PD = (u16*)(ws + WS_PD); u16* UT = (u16*)(ws + WS_UT); u16* YG = (u16*)(ws + WS_YG);
    u16* POOLP = (u16*)(ws + WS_POOLP); u16* S5U = (u16*)(ws + WS_S5U); unsigned char* Q8 = ws + WS_Q; unsigned char* K8 = ws + WS_K;
    unsigned char* VT8 = ws + WS_VT; u16* GATE = (u16*)(ws + WS_GATE);
    unsigned char* YPOOL = ws + WS_YPOOL; unsigned char* YS5 = YPOOL + (size_t)R * 512; unsigned char* YATT = YPOOL + (size_t)R * 1024;
    unsigned char* MERGED8 = YPOOL + (size_t)R * 2048;
    u16* AC = (u16*)(ws + WS_AC); u16* AE = (u16*)(ws + WS_AE);
    float* EB = (float*)(ws + WS_E); _Float16* SCORES = (_Float16*)(ws + WS_SCORES);
    int* EL = (int*)(ws + WS_EL); float* GL = (float*)(ws + WS_GL);
    unsigned char* U8 = ws + WS_U16; unsigned char* V8 = ws + WS_V16;

    if (PH_IN(0)) {
        PH_TID
        u16* scr = (u16*)(lds + wave * 9216);
        const int gw = vb * 8 + wave, NGW = G * 8;
        constexpr int I_WIN = 32 * 160, I_BP = 8 * 32, I_BS = 8 * 32, I_BA = 16 * 32, I_WO = 32 * 32, I_GLU = 8 * 8, I_L = I_WIN + I_BP + I_BS + I_BA + I_WO + I_GLU;
        for (int it = gw; it < 2 * I_L; it += NGW) {
            const int l = it / I_L; int r = it % I_L;
            if (r < I_WIN) {
                if (!GATES_FP4 || r % 160 < 64) transpose_item8(pin(8) + (size_t)l * D * NIN, NIN, ws + WS_WIN + (size_t)l * NIN * D, D, (r / 160) * 64, (r % 160) * 64, (unsigned char*)scr, lane, 32.f);
                else transpose_item4(pin(8) + (size_t)l * D * NIN + 4096, NIN, ws + WS_W4 + (size_t)l * 6144 * 1024, 1024, (r / 160) * 64, (r % 160 - 64) * 64, (unsigned char*)scr, lane, G4_WS);
                continue; } r -= I_WIN;
            if (r < I_BP) { transpose_item8(pin(25) + (size_t)l * 512 * D, D, ws + WS_WBR + (size_t)l * D * D, D, (r / 32) * 64, (r % 32) * 64, (unsigned char*)scr, lane, 16.f); continue; } r -= I_BP;
            if (r < I_BS) { transpose_item8(pin(26) + (size_t)l * 512 * D, D, ws + WS_WBR + (size_t)l * D * D + 512, D, (r / 32) * 64, (r % 32) * 64, (unsigned char*)scr, lane, 16.f); continue; } r -= I_BS;
            if (r < I_BA) { transpose_item8(pin(27) + (size_t)l * 1024 * D, D, ws + WS_WBR + (size_t)l * D * D + 1024, D, (r / 32) * 64, (r % 32) * 64, (unsigned char*)scr, lane, 16.f); continue; } r -= I_BA;
            if (r < I_WO) { transpose_item8(pin(28) + (size_t)l * D * D, D, ws + WS_WOUT + (size_t)l * D * D, D, (r / 32) * 64, (r % 32) * 64, (unsigned char*)scr, lane, 32.f); continue; } r -= I_WO;
            transpose_item(pin(19) + (size_t)l * 512 * 512, 512, (u16*)(ws + WS_WGLU) + (size_t)l * 512 * 512, 512, (r / 8) * 64, (r % 8) * 64, scr, lane);
        }
        const long gt = (long)vb * 512 + tid, NGT = (long)G * 512;
        for (long i = gt; i < 2l * D * D / 4; i += NGT) {
            const float4 v = ((const float4*)pin(29))[i]; uint2 pk; pk.x = cvtpk(v.x, v.y); pk.y = cvtpk(v.z, v.w); ((uint2*)(ws + WS_WQ16))[i] = pk;
        }
        for (long i = gt; i < 2l * 8 * 256 * 256 / 4; i += NGT) {
            const long e = i * 4; const int cd = e & 255, ck = (e >> 8) & 255, hh = (e >> 16) & 7, l = e >> 19;
            const int c = ck >> 7, key = ck & 127, c2 = cd >> 7, d = cd & 127;
            uint2 pk = make_uint2(0u, 0u);
            if (c == c2) { const float4 v = *(const float4*)(pin(30) + ((((size_t)l * 8 + hh) * 2 + c) * 128 + key) * 128 + d); pk.x = cvtpk(v.x, v.y); pk.y = cvtpk(v.z, v.w); }
            ((uint2*)(ws + WS_KPAD))[i] = pk;
        }
        for (long i = gt; i < 2l * 512 * 512; i += NGT) {
            const int k = i & 511, n = (i >> 9) & 511, l = i >> 18;
            float v = 0.f;
            if ((k >> 7) == (n >> 7)) v = pin(9)[(((size_t)l * 4 + (n >> 7)) * 128 + (k & 127)) * 128 + (n & 127)];
            ((u16*)(ws + WS_WPOOL))[i] = (u16)(cvtpk(v, 0.f) & 0xffff);
        }
        for (long i = gt; i < 64 * 16; i += NGT) {
            const int pos = i >> 4, f = i & 15; const float fr = powf(10000.f, -(float)f / 16.f); const float a = (float)pos * fr; float s, c; sincosf(a, &s, &c);
            ROPE[i] = make_float2(c, s);
        }
        {
            float* sil = (float*)(lds + 18432);
            float* red = (float*)lds;
            __syncthreads();
            for (int i = tid; i < 9 * 2048; i += 512) { const int bb = i >> 11, k = i & 2047; const float cv = (bb < 8) ? pin(1)[bb * 2048 + k] : pin(3)[k]; sil[i] = cv * __builtin_amdgcn_rcpf(1.f + __builtin_amdgcn_exp2f(-1.4426950408889634f * cv)); }
            __syncthreads();
            for (int it = vb; it < 2 * 192; it += G) {
                const int l = it / 192, n0 = (it % 192) * 64;
                const float* w = pin(4) + (size_t)l * D * 12288 + n0 + lane;
                float a[9];
#pragma unroll
                for (int bb = 0; bb < 9; ++bb) a[bb] = 0.f;
                const int k0 = wave * 256;
#pragma unroll 32
                for (int k = 0; k < 256; ++k) {
                    const float wv = w[(size_t)(k0 + k) * 12288];
#pragma unroll
                    for (int bb = 0; bb < 9; ++bb) a[bb] += sil[bb * 2048 + k0 + k] * wv;
                }
#pragma unroll
                for (int bb = 0; bb < 9; ++bb) red[(wave * 9 + bb) * 64 + lane] = a[bb];
                __syncthreads();
                for (int i = tid; i < 9 * 64; i += 512) {
                    float s = 0.f;
#pragma unroll
                    for (int wv = 0; wv < 8; ++wv) s += red[wv * 576 + i];
                    const int bb = i >> 6, nn = i & 63;
                    MODS[((size_t)l * 9 + bb) * 12288 + n0 + nn] = s + pin(5)[(size_t)l * 12288 + n0 + nn];
                }
                __syncthreads();
            }
        }
        PH_SEAM(0);
    }

    for (int l = 0; l < 2; ++l) {
        const int P0 = 1 + l * NPL;
        const float* xl_in = pin(0);
        const float* xc_in = (l == 0) ? pin(2) : XC;
        const float* mods = MODS + (size_t)l * 9 * 12288;
        const int Ract = (l == 0) ? R : RL;
        const float lam_init = (l == 0) ? 0.2f : (0.8f - 0.6f * 0.7408182206817179f);
        const unsigned char* WIN8 = ws + WS_WIN + (size_t)l * NIN * D;
        const unsigned char* WBR8 = ws + WS_WBR + (size_t)l * D * D;
        const unsigned char* WOUT8 = ws + WS_WOUT + (size_t)l * D * D;
        const unsigned char* WPK8 = ws + WS_WPK + (size_t)l * D * D;

        if (l == 0 && PH_IN(P0 + 0)) {
            PH_TID
            for (int t = vb; t < 128; t += G) {
                const int l2 = t >> 6, kt = t & 7, hh = (t >> 3) & 7;
                EpiStoreF8 e{ws + WS_WPK + (size_t)l2 * D * D + (size_t)(hh * 256) * D + kt * 256, 32.f};
                gemm_tile<false>((const u16*)(ws + WS_WQ16) + (size_t)l2 * D * D + (size_t)(kt * 256) * D + hh * 256, D,
                          (const u16*)(ws + WS_KPAD) + ((size_t)l2 * 8 + hh) * 65536, 256, 256, shm16, e);
            }
            for (int r = vb * 8 + wave; r < R; r += G * 8) {
                const int bb = (r < RL) ? (r >> 12) : 8;
                const float* xr = (r < RL) ? xl_in + (size_t)r * D : xc_in + (size_t)(r - RL) * D;
                rms_mod_row<true>(xr, pin(6) + l * D, mods + bb * 12288, mods + bb * 12288 + D, (unsigned char*)Hb + (size_t)r * D, lane, GATES_FP4 ? (unsigned*)(ws + WS_H4 + (size_t)r * 1024) : nullptr);
            }
            PH_SEAM(P0 + 0);
        }

        if (PH_IN(P0 + 1)) {
            PH_TID
            constexpr int NTI = NIN / 256, NTJ = R / 256, GM = 8;
            for (int t = vb; t < NTI * NTJ; t += G) {
                const int grp = t / (GM * NTI), rem = t % (GM * NTI), rt = grp * GM + rem % GM, ct = rem / GM;
                const int f0 = ct * 256;
                if (l == 1 && rt >= 128 && !(f0 >= 512 && f0 < 1024) && !(f0 >= 2048 && f0 < 4096)) continue;
                const u16* Wt = (const u16*)(WIN8 + (size_t)f0 * D); const u16* At_ = (const u16*)((const unsigned char*)Hb + (size_t)rt * 256 * D);
                if (f0 >= 3072 && f0 < 4096) {
                    const int b = (rt < 128) ? (rt >> 4) : (rt - 128), key0 = (rt < 128) ? (rt & 15) * 256 : SEQ;
                    EpiV e{VT8 + ((size_t)b * 1024 + (f0 - 3072)) * SK + key0};
                    gemm_tile<true>(At_, D / 2, Wt, D / 2, D / 2, shm16, e);
                } else {
                    EpiG1 e; e.rope = ROPE; e.qscale = 1.f; e.wsc = 1.f / 32.f; e.lat = (rt < 128); e.t0 = (rt & 15) * 256; e.kind = 0;
                    const size_t r0 = (size_t)rt * 256;
                    if (f0 < 512) { e.out = POOLP + r0 * 512 + f0; e.ldo = 512; }
                    else if (f0 < 1024) { e.out = S5U + r0 * 512 + (f0 - 512); e.ldo = 512; }
                    else if (f0 < 2048) { e.out = Q8 + r0 * 1024 + (f0 - 1024); e.ldo = 1024; e.kind = 1; e.qscale = 4.f * 0.125f * 1.4426950408889634f; }
                    else if (f0 < 3072) { e.out = K8 + r0 * 1024 + (f0 - 2048); e.ldo = 1024; e.kind = 2; e.qscale = 0.25f; }
                    else { e.out = (unsigned char*)GATE + r0 * 6144 + (f0 - 4096); e.ldo = 6144; e.kind = 3; e.qscale = 128.f; }
                    if (GATES_FP4 && f0 >= 4096) {
                        e.wsc = 1.f / (G4_HS * G4_WS);
                        gemm_tile<2>((const u16*)(ws + WS_W4 + ((size_t)l * 6144 + (f0 - 4096)) * 1024), D / 4, (const u16*)(ws + WS_H4 + (size_t)rt * 256 * 1024), D / 4, D / 4, shm16, e);
                    } else
                    gemm_tile<true>(Wt, D / 2, At_, D / 2, D / 2, shm16, e);
                }
            }
            PH_SEAM(P0 + 1);
        }

        if (PH_IN(P0 + 2)) {
            PH_TID
            const long gt = (long)vb * 512 + tid, NGT = (long)G * 512;
            for (long i = gt; i < (long)Ract * 64; i += NGT) {
                const int ch = i & 63; const long r = i >> 6;
                const int gi = ch >> 4, win = 2 << gi;
                long base; int t, S;
                if (r < RL) { base = r & ~(long)(SEQ - 1); t = r & (SEQ - 1); S = SEQ; } else { base = RL + ((r - RL) & ~(long)(CTXL - 1)); t = (r - RL) & (CTXL - 1); S = CTXL; }
                const int lo_ = max(t - win / 2, 0), hi_ = min(t + win - 1 - win / 2, S - 1);
                float s[8];
#pragma unroll
                for (int e = 0; e < 8; ++e) s[e] = 0.f;
                uint4 wv[16];
#pragma unroll
                for (int j = 0; j < 16; ++j) { const int tt = min(lo_ + j, hi_); wv[j] = *(const uint4*)(POOLP + (base + tt) * 512 + ch * 8); }
#pragma unroll
                for (int j = 0; j < 16; ++j) if (lo_ + j <= hi_) { const uint4 v = wv[j];
                    s[0] += bflo(v.x); s[1] += bfhi(v.x); s[2] += bflo(v.y); s[3] += bfhi(v.y); s[4] += bflo(v.z); s[5] += bfhi(v.z); s[6] += bflo(v.w); s[7] += bfhi(v.w); }
                const float inv = 1.f / (float)(hi_ - lo_ + 1);
                const uint4 c = *(const uint4*)(POOLP + r * 512 + ch * 8);
                uint4 o;
                o.x = cvtpk(s[0] * inv - bflo(c.x), s[1] * inv - bfhi(c.x)); o.y = cvtpk(s[2] * inv - bflo(c.y), s[3] * inv - bfhi(c.y));
                o.z = cvtpk(s[4] * inv - bflo(c.z), s[5] * inv - bfhi(c.z)); o.w = cvtpk(s[6] * inv - bflo(c.w), s[7] * inv - bfhi(c.w));
                *(uint4*)(PD + r * 512 + ch * 8) = o;
            }
            for (long i = gt; i < 32l * 1088 * 64; i += NGT) {
                const int hf = i & 1, s = (i >> 1) & 31; const long gn = i >> 6; const int n = gn % 1088, g = gn / 1088;
                const long row = (n < 1024) ? ((long)(n >> 7) * SEQ + (n & 127) * S5L + s) : ((long)RL + ((n - 1024) >> 3) * CTXL + ((n - 1024) & 7) * S5L + s);
                *(uint4*)(UT + ((size_t)g * S5N + n) * S5K + s * 16 + hf * 8) = *(const uint4*)(S5U + row * 512 + g * 16 + hf * 8);
            }
            {
            const float* a_re = pin(11) + l * 4096; const float* a_im = pin(12) + l * 4096; const float* ldt = pin(13) + l * 64;
            const float* b_re = pin(14) + (size_t)l * 65536; const float* b_im = pin(15) + (size_t)l * 65536;
            const float* c_re = pin(16) + (size_t)l * 65536; const float* c_im = pin(17) + (size_t)l * 65536;
            const float* dsk = pin(18) + l * 512;
            {
                float* wre = (float*)lds;
                float* wim = wre + 2048;
                float* kdv = wim + 2048;
                for (int it = vb; it < 32 * 32; it += G) {
                    const int g = it >> 5, d = it & 31;
                    __syncthreads();
                    for (int i = tid; i < 2048; i += 512) {
                        const int dir = i >> 10, pp = (i >> 4) & 63, j = i & 15;
                        const int gi = (dir * 32 + g) * 64 + pp;
                        const float ar = a_re[gi], ai = a_im[gi], dt = expf(ldt[dir * 32 + g]);
                        float cr, ci, lr, li; s5_coef(ar, ai, dt, cr, ci); s5_lampow(ar, ai, dt, (float)d, lr, li);
                        const float br = b_re[(size_t)gi * 16 + j], bi = b_im[(size_t)gi * 16 + j];
                        const float bbr = cr * br - ci * bi, bbi = cr * bi + ci * br;
                        wre[i] = lr * bbr - li * bbi; wim[i] = lr * bbi + li * bbr;
                    }
                    __syncthreads();
                    const int dir = tid >> 8, ii = (tid >> 4) & 15, j = tid & 15;
                    const float* cr_ = c_re + ((size_t)(dir * 32 + g) * 16 + ii) * 64; const float* ci_ = c_im + ((size_t)(dir * 32 + g) * 16 + ii) * 64;
                    float kv = 0.f;
#pragma unroll 8
                    for (int pp = 0; pp < 64; ++pp) kv += cr_[pp] * wre[(dir * 64 + pp) * 16 + j] - ci_[pp] * wim[(dir * 64 + pp) * 16 + j];
                    kdv[tid] = kv;
                    __syncthreads();
                    u16* acg = AC + (size_t)g * 512 * S5K;
                    if (d == 0) {
                        if (dir == 0) { const float v = kdv[tid] + kdv[256 + tid] + ((ii == j) ? dsk[g * 16 + ii] : 0.f); const u16 hv = (u16)(cvtpk(v, 0.f) & 0xffff);
                            for (int t = 0; t < 32; ++t) acg[(size_t)(t * 16 + ii) * S5K + t * 16 + j] = hv; }
                    } else {
                        const u16 hv = (u16)(cvtpk(kv, 0.f) & 0xffff);
                        if (dir == 0) { for (int t = d; t < 32; ++t) acg[(size_t)(t * 16 + ii) * S5K + (t - d) * 16 + j] = hv; }
                        else { for (int t = 0; t < 32 - d; ++t) acg[(size_t)(t * 16 + ii) * S5K + (t + d) * 16 + j] = hv; }
                    }
                }
                __syncthreads();
            }
            {
                const long gt = (long)vb * 512 + tid, NGT = (long)G * 512;
                for (long i = gt; i < 32l * 512 * 256; i += NGT) {
                    const int col = i & 255, row = (i >> 8) & 511, g = i >> 17;
                    const int dir = col >> 7, im = (col >> 6) & 1, pp = col & 63, t = row >> 4, ii = row & 15;
                    const int gi = (dir * 32 + g) * 64 + pp;
                    const float dt = expf(ldt[dir * 32 + g]);
                    float lr, li; s5_lampow(a_re[gi], a_im[gi], dt, (dir == 0) ? (float)(t + 1) : (float)(32 - t), lr, li);
                    const float cr = c_re[((size_t)(dir * 32 + g) * 16 + ii) * 64 + pp], ci = c_im[((size_t)(dir * 32 + g) * 16 + ii) * 64 + pp];
                    const float v = im ? -(cr * li + ci * lr) : (cr * lr - ci * li);
                    AC[((size_t)g * 512 + row) * S5K + 512 + col] = (u16)(cvtpk(v, 0.f) & 0xffff);
                }
                for (long i = gt; i < 32l * 256 * 512; i += NGT) {
                    const int col = i & 511, row = (i >> 9) & 255, g = i >> 17;
                    const int dir = row >> 7, im = (row >> 6) & 1, pp = row & 63, s = col >> 4, j = col & 15;
                    const int gi = (dir * 32 + g) * 64 + pp;
                    const float ar = a_re[gi], ai = a_im[gi], dt = expf(ldt[dir * 32 + g]);
                    float cr, ci, lr, li; s5_coef(ar, ai, dt, cr, ci); s5_lampow(ar, ai, dt, (dir == 0) ? (float)(31 - s) : (float)s, lr, li);
                    const float br = b_re[(size_t)gi * 16 + j], bi = b_im[(size_t)gi * 16 + j];
                    const float bbr = cr * br - ci * bi, bbi = cr * bi + ci * br;
                    const float v = im ? (lr * bbi + li * bbr) : (lr * bbr - li * bbi);
                    AE[((size_t)g * 256 + row) * 512 + col] = (u16)(cvtpk(v, 0.f) & 0xffff);
                }
            }
            }
            PH_SEAM(P0 + 2);
        }

        if (PH_IN(P0 + 3)) {
            PH_TID
            const u16* WPOOL = (const u16*)(ws + WS_WPOOL) + (size_t)l * 512 * 512;
            const int NT_POOL = 2 * (Ract / 256); constexpr int NT_E = 32 * 5;
            for (int t = vb; t < NT_POOL; t += G) {
                const int ct = t & 1, rt = t >> 1;
                EpiPool e{YPOOL + (size_t)rt * 256 * 512 + ct * 256, pin(10) + l * 512 + ct * 256};
                gemm_tile<false>(WPOOL + (size_t)ct * 256 * 512, 512, PD + (size_t)rt * 256 * 512, 512, 512, shm16, e);
            }
            for (int u = (vb + G - (NT_POOL % G)) % G; u < NT_E; u += G) {
                const int g = u / 5, nt = u % 5;
                EpiS5E e{EB + ((size_t)g * S5N + nt * 256) * 256};
                gemm_tile<false>(AE + (size_t)g * 256 * 512, 512, UT + ((size_t)g * S5N + nt * 256) * S5K, S5K, 512, shm16, e);
            }
            PH_SEAM(P0 + 3);
        }

        if (PH_IN(P0 + 4)) {
            PH_TID
            int vbs = vb; asm volatile("" : "+s"(vbs));
            if (vbs < 64) {
                const int gi = vbs * 512 + tid; const int pp = gi & 63, dir = (gi >> 6) & 1, g = (gi >> 7) & 31, b = gi >> 12;
                const int pi = (dir * 32 + g) * 64 + pp;
                const float dt = expf(pin(13)[l * 64 + dir * 32 + g]);
                float Lr, Li; s5_lampow(pin(11)[l * 4096 + pi], pin(12)[l * 4096 + pi], dt, 32.f, Lr, Li);
                float hr = 0.f, hi_ = 0.f;
                for (int st0 = 0; st0 < 136; st0 += 17) {
                    float er[17], ei[17]; size_t gnv[17];
#pragma unroll
                    for (int j = 0; j < 17; ++j) {
                        const int st = st0 + j; int n;
                        if (dir == 0) n = (st < 8) ? (1024 + b * 8 + st) : (b * 128 + (st - 8));
                        else n = (st < 8) ? (1024 + b * 8 + (7 - st)) : (b * 128 + (135 - st));
                        gnv[j] = (size_t)g * S5N + n;
                        er[j] = EB[gnv[j] * 256 + dir * 128 + pp]; ei[j] = EB[gnv[j] * 256 + dir * 128 + 64 + pp];
                    }
#pragma unroll
                    for (int j = 0; j < 17; ++j) {
                        u16* ho = UT + gnv[j] * S5K + 512 + dir * 128 + pp;
                        ho[0] = (u16)(cvtpk(hr, 0.f) & 0xffff); ho[64] = (u16)(cvtpk(hi_, 0.f) & 0xffff);
                        const float nr = Lr * hr - Li * hi_ + er[j], ni = Lr * hi_ + Li * hr + ei[j];
                        hr = nr; hi_ = ni;
                    }
                }
            }
            float s1 = 0.f, s2 = 0.f;
            { s1 = pin(20)[l * 64 + lane] * pin(21)[l * 64 + lane]; s2 = pin(22)[l * 64 + lane] * pin(23)[l * 64 + lane];
#pragma unroll
              for (int of = 32; of > 0; of >>= 1) { s1 += __shfl_xor(s1, of); s2 += __shfl_xor(s2, of); } }
            const float lam = expf(s1) - expf(s2) + lam_init;
            const int nunits = 2048 + ((l == 0) ? 128 : 0);
            attn_prep((char*)lds);
            const bool shiftc = (l == 0) && (G == 256);
            for (int u0 = vb; u0 < nunits + (shiftc ? 128 : 0); u0 += G) {
                int u = u0;
                if (shiftc && u0 >= 2048) { if (u0 < 2048 + 128) continue; u = u0 - 128; }
                int b, hd, qrow0, k_lo;
                if (u < 2048) { b = u >> 8; hd = (u >> 5) & 7; qrow0 = b * SEQ + (u & 31) * 128; k_lo = 0; }
                else { const int v = u - 2048; b = v >> 4; hd = (v >> 1) & 7; qrow0 = RL + b * CTXL + (v & 1) * 128; k_lo = 32; }
                attn_unit(Q8, K8, VT8, YATT, b, hd, qrow0, k_lo, 34, lam, 1.f - lam_init, pin(24) + l * 128, (char*)lds);
            }
            PH_SEAM(P0 + 4);
        }

        if (PH_IN(P0 + 5)) {
            PH_TID
            const int ntn = (l == 0) ? 10 : 8;
            for (int t = vb; t < 32 * ntn; t += G) {
                const int g = t / ntn, r = t % ntn, it = r & 1, nt = r >> 1;
                EpiS5Y e{YG, g, it, nt};
                gemm_tile<false>(AC + ((size_t)g * 512 + it * 256) * S5K, S5K, UT + ((size_t)g * S5N + nt * 256) * S5K, S5K, S5K, shm16, e);
            }
            PH_SEAM(P0 + 5);
        }

        if (PH_IN(P0 + 6)) {
            PH_TID
            const u16* WGLU = (const u16*)(ws + WS_WGLU) + (size_t)l * 512 * 512;
            for (int t = vb; t < 2 * (Ract / 256); t += G) {
                const int ct = t & 1, rt = t >> 1;
                const size_t o = (size_t)rt * 256 * 512 + ct * 256;
                EpiGlu e{YS5 + o, YG + o};
                gemm_tile<false>(WGLU + (size_t)ct * 256 * 512, 512, YG + (size_t)rt * 256 * 512, 512, 512, shm16, e);
            }
            PH_SEAM(P0 + 6);
        }

        if (PH_IN(P0 + 7)) {
            PH_TID
            constexpr int NTI = 8, GM = 8; const int NTJ = Ract / 256;
            for (int t = vb; t < NTI * NTJ; t += G) {
                const int grp = t / (GM * NTI), rem = t % (GM * NTI), rt = grp * GM + rem % GM, ct = rem / GM;
                const size_t r0 = (size_t)rt * 256; const int n0 = ct * 256;
                Acc macc = {};
#pragma unroll 1
                for (int br = 0; br < 3; ++br) {
                    EpiMerge e{MERGED8 + r0 * D + n0, (const unsigned char*)GATE + r0 * 6144 + br * 2048 + n0, br};
                    const u16* Wt = (const u16*)(WBR8 + (size_t)n0 * D + ((br == 0) ? 0 : (br == 1) ? 512 : 1024));
                    const u16* Ab = (const u16*)((br == 0) ? YPOOL + r0 * 512 : (br == 1) ? YS5 + r0 * 512 : YATT + r0 * 1024);
                    gemm_tile_acc<true>(Wt, D / 2, Ab, (br == 2) ? 512 : 256, (br == 2) ? 512 : 256, shm16, macc, e);
                }
            }
            PH_SEAM(P0 + 7);
        }

        if (PH_IN(P0 + 8)) {
            PH_TID
            constexpr int NTI = 8, GM = 8; const int NTJ = Ract / 256;
            for (int t = vb; t < NTI * NTJ; t += G) {
                const int grp = t / (GM * NTI), rem = t % (GM * NTI), rt = grp * GM + rem % GM, ct = rem / GM;
                const size_t r0 = (size_t)rt * 256; const int n0 = ct * 256;
                const int bb = (rt < 128) ? (rt >> 4) : 8;
                const void* xin = (rt < 128) ? ((l == 0) ? (const void*)(pin(0) + r0 * D + n0) : (const void*)(XB + r0 * D + n0)) : (const void*)(xc_in + (r0 - RL) * D + n0);
                void* xout = (rt < 128) ? (void*)(XB + r0 * D + n0) : (void*)(XC + (r0 - RL) * D + n0);
                EpiRes e{xin, xout, mods + bb * 12288 + 2 * D + n0, 1.f / 128.f, (rt < 128) && (l == 1), (rt < 128)};
                gemm_tile<true>((const u16*)(WOUT8 + (size_t)n0 * D), D / 2, (const u16*)(MERGED8 + r0 * D), D / 2, D / 2, shm16, e);
            }
            PH_SEAM(P0 + 8);
        }

        if (PH_IN(P0 + 9)) {
            PH_TID
            for (int r = vb * 8 + wave; r < Ract; r += G * 8) {
                const int bb = (r < RL) ? (r >> 12) : 8;
                if (r < RL) rms_mod_row<true, true>(XB + (size_t)r * D, pin(7) + l * D, mods + bb * 12288 + 3 * D, mods + bb * 12288 + 4 * D, MERGED8 + (size_t)r * D, lane);
                else rms_mod_row<true, false>(XC + (size_t)(r - RL) * D, pin(7) + l * D, mods + bb * 12288 + 3 * D, mods + bb * 12288 + 4 * D, MERGED8 + (size_t)r * D, lane);
            }
            const long gt = (long)vb * 512 + tid, NGT = (long)G * 512;
            for (long i = gt; i < 9l * 3 * 2048; i += NGT) {
                const int b9 = (int)(i / 6144), vs_ = (int)(i / 2048) % 3, pp = (int)(i & 2047);
                const int c = ((pp >> 2) & 63) * 32 + (pp >> 8) * 4 + (pp & 3);
                float val;
                if (vs_ == 0) val = mods[b9 * 12288 + 5 * D + c];
                else if (l == 0) { const float* m1 = MODS + (size_t)9 * 12288 + b9 * 12288; val = (vs_ == 1) ? pin(6)[D + c] * (1.f + m1[D + c]) : m1[c]; }
                else val = pin(33)[c];
                ((float*)(ws + WS_PERM))[i] = val;
            }
            const float4* us = (const float4*)(pin(31) + (size_t)l * 16384 * D); const float4* vs = (const float4*)(pin(32) + (size_t)l * 16384 * D);
            for (long i = gt; i < 16384l * D / 32; i += NGT) {
                u32x4 pu, pv;
#pragma unroll
                for (int dd = 0; dd < 4; ++dd) {
                    const float4 a0 = us[i * 8 + dd * 2], a1 = us[i * 8 + dd * 2 + 1], c0 = vs[i * 8 + dd * 2], c1 = vs[i * 8 + dd * 2 + 1];
                    unsigned x = 0u, y = 0u;
                    x = __builtin_amdgcn_cvt_scalef32_pk_fp4_f32(x, a0.x * PEER_USC, a0.y * PEER_USC, 1.0f, 0); x = __builtin_amdgcn_cvt_scalef32_pk_fp4_f32(x, a0.z * PEER_USC, a0.w * PEER_USC, 1.0f, 1);
                    x = __builtin_amdgcn_cvt_scalef32_pk_fp4_f32(x, a1.x * PEER_USC, a1.y * PEER_USC, 1.0f, 2); x = __builtin_amdgcn_cvt_scalef32_pk_fp4_f32(x, a1.z * PEER_USC, a1.w * PEER_USC, 1.0f, 3);
                    y = __builtin_amdgcn_cvt_scalef32_pk_fp4_f32(y, c0.x * PEER_VSC, c0.y * PEER_VSC, 1.0f, 0); y = __builtin_amdgcn_cvt_scalef32_pk_fp4_f32(y, c0.z * PEER_VSC, c0.w * PEER_VSC, 1.0f, 1);
                    y = __builtin_amdgcn_cvt_scalef32_pk_fp4_f32(y, c1.x * PEER_VSC, c1.y * PEER_VSC, 1.0f, 2); y = __builtin_amdgcn_cvt_scalef32_pk_fp4_f32(y, c1.z * PEER_VSC, c1.w * PEER_VSC, 1.0f, 3);
                    pu[dd] = x; pv[dd] = y;
                }
                ((u32x4*)U8)[i] = pu; ((u32x4*)V8)[i] = pv;
            }
            PH_SEAM(P0 + 9);
        }

        if (PH_IN(P0 + 10)) {
            PH_TID
            constexpr int NTI = 8, GM = 8; const int NTJ = Ract / 256;
            for (int t = vb; t < NTI * NTJ; t += G) {
                const int grp = t / (GM * NTI), rem = t % (GM * NTI), rt = grp * GM + rem % GM, ct = rem / GM;
                const size_t r0 = (size_t)rt * 256; const int n0 = ct * 256;
                EpiF16 e{SCORES + r0 * 2048 + n0, 1.f / 32.f};
                gemm_tile<1>((const u16*)(WPK8 + (size_t)n0 * D), D / 2, (const u16*)(MERGED8 + r0 * D), D / 2, D / 2, shm16, e);
            }
            PH_SEAM(P0 + 10);
        }

        if (PH_IN(P0 + 11)) {
            PH_TID
            const long gt = (long)vb * 512 + tid, NGT = (long)G * 512;
            for (long i = gt; i < (long)Ract * 8; i += NGT) {
                const u32x4* sc = (const u32x4*)(SCORES + i * 256);
                unsigned L1[16], L2[16];
#pragma unroll
                for (int k = 0; k < 16; ++k) { L1[k] = 0u; L2[k] = 0u; }
#pragma unroll 1
                for (int gq = 0; gq < 8; ++gq) {
                    const u32x4 a0 = sc[2 * gq], a1 = sc[2 * gq + 1], c0 = sc[16 + 2 * gq], c1 = sc[16 + 2 * gq + 1];
                    unsigned B1[16], B2[16];
#pragma unroll
                    for (int d = 0; d < 4; ++d) {
                        const unsigned x0 = a0[d], x1 = a1[d], y0 = c0[d], y1 = c1[d];
                        const h16x2 xa = __builtin_bit_cast(h16x2, x0), xb = __builtin_bit_cast(h16x2, x1), ya = __builtin_bit_cast(h16x2, y0), yb = __builtin_bit_cast(h16x2, y1);
                        const unsigned id = (unsigned)(16 * gq + 2 * d);
                        B1[2 * d] = (fenc((float)xa[0]) & ~127u) | id; B1[2 * d + 1] = (fenc((float)xa[1]) & ~127u) | (id + 1);
                        B1[8 + 2 * d] = (fenc((float)xb[0]) & ~127u) | (id + 8); B1[8 + 2 * d + 1] = (fenc((float)xb[1]) & ~127u) | (id + 9);
                        B2[2 * d] = (fenc((float)ya[0]) & ~127u) | id; B2[2 * d + 1] = (fenc((float)ya[1]) & ~127u) | (id + 1);
                        B2[8 + 2 * d] = (fenc((float)yb[0]) & ~127u) | (id + 8); B2[8 + 2 * d + 1] = (fenc((float)yb[1]) & ~127u) | (id + 9);
                    }
                    sort16_desc(B1); merge16_desc(L1, B1);
                    sort16_desc(B2); merge16_desc(L2, B2);
                }
                unsigned T[16];
#pragma unroll
                for (int k = 0; k < 16; ++k) T[k] = 0u;
#pragma unroll
                for (int a = 0; a < 16; ++a) {
                    const float va = fdec(L1[a] & ~127u); const unsigned ia = L1[a] & 127u;
#pragma unroll
                    for (int c = 0; c < 16; ++c) {
                        if ((a + 1) * (c + 1) <= 16) {
                            const float vs = va + fdec(L2[c] & ~127u);
                            INS32(T, (fenc(vs) & ~0x3FFFu) | (ia << 7) | (L2[c] & 127u));
                        }
                    }
                }
                float w[16]; float sum = 0.f; const float mx = fdec(T[0] & ~0x3FFFu);
#pragma unroll
                for (int k = 0; k < 16; ++k) { w[k] = __expf(fdec(T[k] & ~0x3FFFu) - mx); sum += w[k]; }
                const float inv = 1.f / sum;
                int4* eo = (int4*)(EL + i * 16); float4* go = (float4*)(GL + i * 16);
#pragma unroll
                for (int k = 0; k < 4; ++k) {
                    eo[k] = make_int4((int)(T[4 * k] & 0x3FFFu), (int)(T[4 * k + 1] & 0x3FFFu), (int)(T[4 * k + 2] & 0x3FFFu), (int)(T[4 * k + 3] & 0x3FFFu));
                    go[k] = make_float4(w[4 * k] * inv, w[4 * k + 1] * inv, w[4 * k + 2] * inv, w[4 * k + 3] * inv);
                }
            }
            PH_SEAM(P0 + 11);
        }

        if (PH_IN(P0 + 12)) {
            PH_TID
            for (int r = vb * 8 + wave; r < Ract; r += G * 8) {
                const int e0 = EL[(size_t)r * 128 + lane], e1 = EL[(size_t)r * 128 + 64 + lane];
                const float g0 = GL[(size_t)r * 128 + lane], g1 = GL[(size_t)r * 128 + 64 + lane];
                h16x2 hh[16];
                {
                    const unsigned char* hrow = MERGED8 + (size_t)r * D + lane * 32;
#pragma unroll
                    for (int c2 = 0; c2 < 2; ++c2) { const u32x4 t4 = *(const u32x4*)(hrow + c2 * 16);
#pragma unroll
                        for (int d = 0; d < 4; ++d) { const unsigned td = t4[d];
                            hh[c2 * 8 + 2 * d] = __builtin_amdgcn_cvt_scalef32_pk_f16_fp8(td, 1.0f, false); hh[c2 * 8 + 2 * d + 1] = __builtin_amdgcn_cvt_scalef32_pk_f16_fp8(td, 1.0f, true); } }
                }
                float w0 = 0.f, w1 = 0.f;
#pragma unroll 1
                for (int hd = 0; hd < 8; ++hd) {
                    const int esel = (hd < 4) ? e0 : e1; const int lb = (hd & 3) * 16;
                    u32x4 ua[16];
#pragma unroll
                    for (int k = 0; k < 16; ++k) { const int ek = __builtin_amdgcn_readlane(esel, lb + k); ua[k] = *(const u32x4*)(U8 + (size_t)ek * (D / 2) + lane * 16); }
                    float part[16];
#pragma unroll
                    for (int k = 0; k < 16; ++k) {
                        h16x2 acc = (h16x2){(_Float16)0.f, (_Float16)0.f};
#pragma unroll
                        for (int d = 0; d < 4; ++d) {
                            acc = __builtin_elementwise_fma(CVT4H(ua[k][d], 0), hh[4 * d + 0], acc);
                            acc = __builtin_elementwise_fma(CVT4H(ua[k][d], 1), hh[4 * d + 1], acc);
                            acc = __builtin_elementwise_fma(CVT4H(ua[k][d], 2), hh[4 * d + 2], acc);
                            acc = __builtin_elementwise_fma(CVT4H(ua[k][d], 3), hh[4 * d + 3], acc);
                        }
                        part[k] = (float)acc[0] + (float)acc[1];
                    }
                    float p8[8], p4[4], p2[2], p1;
#pragma unroll
                    for (int k = 0; k < 8; ++k) { const auto x_ = __builtin_amdgcn_permlane32_swap(__float_as_uint(part[k]), __float_as_uint(part[8 + k]), false, false);
                        p8[k] = __uint_as_float(x_[0]) + __uint_as_float(x_[1]); }
#pragma unroll
                    for (int k = 0; k < 4; ++k) { const auto x_ = __builtin_amdgcn_permlane16_swap(__float_as_uint(p8[k]), __float_as_uint(p8[4 + k]), false, false);
                        p4[k] = __uint_as_float(x_[0]) + __uint_as_float(x_[1]); }
                    { const bool up_ = lane & 8;
#pragma unroll
                      for (int k = 0; k < 2; ++k) { const float keep = up_ ? p4[2 + k] : p4[k], send = up_ ? p4[k] : p4[2 + k]; p2[k] = keep + __shfl_xor(send, 8); } }
                    { const bool up_ = lane & 4; const float keep = up_ ? p2[1] : p2[0], send = up_ ? p2[0] : p2[1]; p1 = keep + __shfl_xor(send, 4); }
                    p1 += __shfl_xor(p1, 2); p1 += __shfl_xor(p1, 1);
                    const float tv = __shfl(p1, 4 * (lane & 15));
                    if ((lane >> 4) == (hd & 3)) { if (hd < 4) w0 = tv; else w1 = tv; }
                }
                GL[(size_t)r * 128 + lane] = g0 * gelu_tanh(w0 * (1.f / PEER_USC)); GL[(size_t)r * 128 + 64 + lane] = g1 * gelu_tanh(w1 * (1.f / PEER_USC));
            }
            PH_SEAM(P0 + 12);
        }

        if (PH_IN(P0 + 13)) {
            PH_TID
            for (int r = vb * 8 + wave; r < Ract; r += G * 8) {
                const int bb = (r < RL) ? (r >> 12) : 8;
                const int e0 = EL[(size_t)r * 128 + lane], e1 = EL[(size_t)r * 128 + 64 + lane];
                const float w0 = GL[(size_t)r * 128 + lane], w1 = GL[(size_t)r * 128 + 64 + lane];
                h16x2 oo[16];
#pragma unroll
                for (int i = 0; i < 16; ++i) oo[i] = (h16x2){(_Float16)0.f, (_Float16)0.f};
#pragma unroll 1
                for (int hd = 0; hd < 8; ++hd) {
                    const int esel = (hd < 4) ? e0 : e1; const float wsel = (hd < 4) ? w0 : w1; const int lb = (hd & 3) * 16;
                    u32x4 va[16]; float wk[16];
#pragma unroll
                    for (int k = 0; k < 16; ++k) {
                        wk[k] = __int_as_float(__builtin_amdgcn_readlane(__float_as_int(wsel), lb + k));
                        const int ek = __builtin_amdgcn_readlane(esel, lb + k);
                        va[k] = *(const u32x4*)(V8 + (size_t)ek * (D / 2) + lane * 16);
                    }
#pragma unroll
                    for (int k = 0; k < 16; ++k) {
                        const _Float16 wh = (_Float16)wk[k]; const h16x2 w2 = (h16x2){wh, wh};
#pragma unroll
                        for (int d = 0; d < 4; ++d) {
                            oo[4 * d + 0] = __builtin_elementwise_fma(CVT4H(va[k][d], 0), w2, oo[4 * d + 0]);
                            oo[4 * d + 1] = __builtin_elementwise_fma(CVT4H(va[k][d], 1), w2, oo[4 * d + 1]);
                            oo[4 * d + 2] = __builtin_elementwise_fma(CVT4H(va[k][d], 2), w2, oo[4 * d + 2]);
                            oo[4 * d + 3] = __builtin_elementwise_fma(CVT4H(va[k][d], 3), w2, oo[4 * d + 3]);
                        }
                    }
                }
                const bool lat = r < RL;
                float* xr = XC + (size_t)(lat ? 0 : r - RL) * D + lane * 32;
                u16* xb = XB + (size_t)(lat ? r : 0) * D + lane * 32;
                const float* pvec = (const float*)(ws + WS_PERM) + (size_t)bb * 6144 + lane * 4;
                float4 xv[8]; float ss = 0.f;
                if (lat) {
#pragma unroll
                    for (int c = 0; c < 4; ++c) { const u32x4 t = *(const u32x4*)(xb + c * 8); const unsigned t0 = t[0], t1 = t[1], t2 = t[2], t3 = t[3];
                        xv[2 * c] = make_float4(bflo(t0), bfhi(t0), bflo(t1), bfhi(t1)); xv[2 * c + 1] = make_float4(bflo(t2), bfhi(t2), bflo(t3), bfhi(t3)); }
                } else {
#pragma unroll
                    for (int q4 = 0; q4 < 8; ++q4) xv[q4] = *(const float4*)(xr + q4 * 4);
                }
#pragma unroll
                for (int q4 = 0; q4 < 8; ++q4) {
                    float4 x = xv[q4]; const float4 gg = *(const float4*)(pvec + q4 * 256);
                    x.x += gg.x * (float)oo[2 * q4][0] * (1.f / PEER_VSC); x.y += gg.y * (float)oo[2 * q4][1] * (1.f / PEER_VSC); x.z += gg.z * (float)oo[2 * q4 + 1][0] * (1.f / PEER_VSC); x.w += gg.w * (float)oo[2 * q4 + 1][1] * (1.f / PEER_VSC);
                    xv[q4] = x; ss += x.x * x.x + x.y * x.y + x.z * x.z + x.w * x.w;
                }
#pragma unroll
                for (int of = 32; of > 0; of >>= 1) ss += __shfl_xor(ss, of);
                const float inv = rsqrtf(ss * (1.f / 2048.f) + 1e-6f);
                if (l == 0) {
                    unsigned* ho = (unsigned*)((unsigned char*)Hb + (size_t)r * D + lane * 32);
                    if (lat) {
#pragma unroll
                        for (int c = 0; c < 4; ++c) { u32x4 t; t[0] = cvtpk(xv[2 * c].x, xv[2 * c].y); t[1] = cvtpk(xv[2 * c].z, xv[2 * c].w); t[2] = cvtpk(xv[2 * c + 1].x, xv[2 * c + 1].y); t[3] = cvtpk(xv[2 * c + 1].z, xv[2 * c + 1].w);
                            *(u32x4*)(xb + c * 8) = t; }
                    } else {
#pragma unroll
                        for (int q4 = 0; q4 < 8; ++q4) *(float4*)(xr + q4 * 4) = xv[q4];
                    }
                    unsigned hq[8], h4q[4];
#pragma unroll
                    for (int q4 = 0; q4 < 8; ++q4) {
                        const float4 ga = *(const float4*)(pvec + 2048 + q4 * 256), sh = *(const float4*)(pvec + 4096 + q4 * 256);
                        const float y0 = xv[q4].x * inv * ga.x + sh.x, y1 = xv[q4].y * inv * ga.y + sh.y, y2 = xv[q4].z * inv * ga.z + sh.z, y3 = xv[q4].w * inv * ga.w + sh.w;
                        hq[q4] = pack4f8(y0, y1, y2, y3);
                        unsigned f4;
                        if ((q4 & 1) == 0) { f4 = __builtin_amdgcn_cvt_scalef32_pk_fp4_f32(0u, y0 * G4_HS, y1 * G4_HS, 1.0f, 0); f4 = __builtin_amdgcn_cvt_scalef32_pk_fp4_f32(f4, y2 * G4_HS, y3 * G4_HS, 1.0f, 1); }
                        else { f4 = __builtin_amdgcn_cvt_scalef32_pk_fp4_f32(h4q[q4 >> 1], y0 * G4_HS, y1 * G4_HS, 1.0f, 2); f4 = __builtin_amdgcn_cvt_scalef32_pk_fp4_f32(f4, y2 * G4_HS, y3 * G4_HS, 1.0f, 3); }
                        h4q[q4 >> 1] = f4;
                    }
                    if (GATES_FP4) *(u32x4*)(ws + WS_H4 + (size_t)r * 1024 + lane * 16) = (u32x4){h4q[0], h4q[1], h4q[2], h4q[3]};
                    *(u32x4*)(ho) = (u32x4){hq[0], hq[1], hq[2], hq[3]}; *(u32x4*)(ho + 4) = (u32x4){hq[4], hq[5], hq[6], hq[7]};
                } else {
                    float* ob = (float*)lds + (size_t)wave * (64 * 36);
#pragma unroll
                    for (int q4 = 0; q4 < 8; ++q4) { const float4 gn = *(const float4*)(pvec + 2048 + q4 * 256);
                        *(float4*)(ob + lane * 36 + q4 * 4) = make_float4(xv[q4].x * inv * gn.x, xv[q4].y * inv * gn.y, xv[q4].z * inv * gn.z, xv[q4].w * inv * gn.w); }
                    float* op = p.out + (size_t)r * D + lane * 4;
#pragma unroll
                    for (int k = 0; k < 8; ++k) {
                        *(float4*)(op + k * 256) = *(const float4*)(ob + (k * 8 + (lane >> 3)) * 36 + (lane & 7) * 4); }
                }
            }
            PH_SEAM(P0 + 13);
        }
    }

}

extern "C" void kernel_launch(void* const* d_in, const int* in_sizes, int n_in, void* d_out, int out_size, void* d_ws, size_t ws_size, hipStream_t stream) {
    static int grid = 0;
    if (grid == 0) {
        if (n_in != 34 || out_size != RL * D || ws_size < WS_END) { fprintf(stderr, "kernel_launch: unexpected shapes (n_in %d out %d ws %zu need %zu)\n", n_in, out_size, ws_size, (size_t)WS_END); grid = -1; return; }
        int dev = 0, cus = 0;
        if (hipGetDevice(&dev) != hipSuccess || hipDeviceGetAttribute(&cus, hipDeviceAttributeMultiprocessorCount, dev) != hipSuccess) { grid = -1; return; }
        if (hipFuncSetAttribute((const void*)fwd_kernel, hipFuncAttributeMaxDynamicSharedMemorySize, LDS_BYTES) != hipSuccess) { fprintf(stderr, "kernel_launch: hipFuncSetAttribute failed\n"); grid = -1; return; }
        int per_cu = 0;
        if (hipOccupancyMaxActiveBlocksPerMultiprocessor(&per_cu, (const void*)fwd_kernel, 512, LDS_BYTES) != hipSuccess || per_cu < 1) { fprintf(stderr, "kernel_launch: occupancy query says %d\n", per_cu); }
        (void)hipGetLastError();
        grid = cus;
    }
    if (grid < 0) return;
    (void)hipMemsetAsync((char*)d_ws + WS_CTL, 0, 16384, stream);
    Params p{};
    for (int i = 0; i < 34; ++i) p.in[i] = (const float*)d_in[i];
    p.out = (float*)d_out; p.ws = (unsigned char*)d_ws;
#if ONE_LAUNCH
    p.ph_lo = 0; p.ph_hi = NPHASE;
    hipLaunchKernelGGL(fwd_kernel, dim3(grid), dim3(512), LDS_BYTES, stream, p);
#else
    for (int ph = 0; ph < NPHASE; ++ph) { p.ph_lo = ph; p.ph_hi = ph + 1; hipLaunchKernelGGL(fwd_kernel, dim3(grid), dim3(512), LDS_BYTES, stream, p); }
#endif
}
```

```cpp
#include <hip/hip_runtime.h>
#include <stdint.h>
#include <stdio.h>

#ifndef ONE_LAUNCH
#define ONE_LAUNCH 1
#endif
#define PEER_USC 90.f
#define PEER_VSC 2.f
#ifndef GATES_FP4
#define GATES_FP4 1
#endif
#define G4_HS 1.5f
#define G4_WS 90.f

typedef unsigned short u16;
typedef __attribute__((ext_vector_type(8))) short bf16x8;
typedef __attribute__((ext_vector_type(4))) float f32x4;
typedef __attribute__((ext_vector_type(2))) __bf16 bf16x2v;
typedef __attribute__((ext_vector_type(4))) unsigned u32x4;
typedef __attribute__((ext_vector_type(2))) float f32x2;
typedef __attribute__((ext_vector_type(2))) _Float16 h16x2;
#define CVT4H(p, sel) __builtin_bit_cast(h16x2, __builtin_amdgcn_cvt_scalef32_pk_f16_fp4((p), 1.0f, (sel)))
typedef __attribute__((ext_vector_type(8))) int v8i;
typedef __attribute__((ext_vector_type(4))) int v4i;

constexpr int D = 2048, NB = 8, SEQ = 4096, CTXL = 256;
constexpr int RL = NB * SEQ, RC = NB * CTXL, R = RL + RC;
constexpr int NIN = 10240, SK = SEQ + CTXL;
constexpr int NPL = 14;
constexpr int NPHASE = 1 + 2 * NPL;
constexpr int S5L = 32, S5N = 1280, S5K = 768;
constexpr int LDS_BYTES = 139264;
constexpr int BAR_LDS_OFF = 131072;

constexpr size_t MB = 1ull << 20;
constexpr size_t al(size_t x) { return (x + 255) & ~(size_t)255; }
constexpr size_t WS_CTL = 0;
constexpr size_t WS_MODS = 65536;
constexpr size_t WS_ROPE = WS_MODS + al(2ull * 9 * 12288 * 4);
constexpr size_t WS_XC = WS_ROPE + al(64 * 16 * 8);
constexpr size_t WS_WIN = WS_XC + al((size_t)RC * D * 4);
constexpr size_t WS_WBR = WS_WIN + al(2ull * NIN * D * 2);
constexpr size_t WS_WOUT = WS_WBR + al(2ull * D * D * 2);
constexpr size_t WS_WPK = WS_WOUT + al(2ull * D * D * 2);
constexpr size_t WS_WQ16 = WS_WPK + al(2ull * D * D * 2);
constexpr size_t WS_KPAD = WS_WQ16 + al(2ull * D * D * 2);
constexpr size_t WS_WGLU = WS_KPAD + al(2ull * 8 * 256 * 256 * 2);
constexpr size_t WS_WPOOL = WS_WGLU + al(2ull * 512 * 512 * 2);
constexpr size_t WS_AC = WS_WPOOL + al(2ull * 512 * 512 * 2);
constexpr size_t WS_AE = WS_AC + al(32ull * 512 * S5K * 2);
constexpr size_t WS_H = WS_AE + al(32ull * 256 * 512 * 2);
constexpr size_t WS_PD = WS_H;
constexpr size_t WS_UT = WS_PD + al((size_t)R * 512 * 2);
constexpr size_t WS_YG = WS_UT + al(32ull * S5N * S5K * 2);
constexpr size_t WS_PROJ = WS_H + al((size_t)R * D * 2);
constexpr size_t WS_POOLP = WS_PROJ;
constexpr size_t WS_S5U = WS_POOLP + al((size_t)R * 512 * 2);
constexpr size_t WS_Q = WS_S5U + al((size_t)R * 512 * 2);
constexpr size_t WS_K = WS_Q + al((size_t)R * 1024 * 2);
constexpr size_t WS_VT = WS_K + al((size_t)R * 1024 * 2);
constexpr size_t WS_GATE = WS_VT + al((size_t)NB * 1024 * SK * 2);
constexpr size_t WS_YPOOL = WS_GATE + al((size_t)R * 6144 * 2);
constexpr size_t WS_YS5 = WS_YPOOL + al((size_t)R * 512 * 2);
constexpr size_t WS_YATT = WS_YS5 + al((size_t)R * 512 * 2);
constexpr size_t WS_END = WS_YATT + al((size_t)R * 1024 * 2);
constexpr size_t WS_XB = WS_GATE + al((size_t)R * 6144);
static_assert(WS_XB + (size_t)RL * D * 2 <= WS_YPOOL, "bf16 residual stream fits behind the fp8 gates");
constexpr size_t WS_PERM = WS_WIN + 2ull * NIN * D;
constexpr size_t WS_W4 = WS_PERM + 262144;
static_assert(WS_W4 + 2ull * 6144 * 1024 <= WS_WBR, "permuted modulation vectors and fp4 gate weights fit behind the fp8 in-projection weights");
constexpr size_t WS_H4 = WS_XB + al((size_t)RL * D * 2);
static_assert(WS_H4 + (size_t)R * 1024 <= WS_YPOOL, "fp4 h fits behind the bf16 residual stream");
constexpr size_t WS_E = WS_POOLP;
constexpr size_t WS_SCORES = WS_GATE;
constexpr size_t WS_EL = WS_POOLP;
constexpr size_t WS_GL = WS_S5U;
constexpr size_t WS_U16 = WS_Q;
constexpr size_t WS_V16 = WS_K;
static_assert(32ull * S5N * 256 * 4 <= 2 * al((size_t)R * 512 * 2), "E fits");
static_assert(16384ull * 2048 * 2 <= al((size_t)R * 1024 * 2), "peer table fits");
static_assert((size_t)R * 4096 <= WS_END - WS_YPOOL, "fp8 branch outputs + merged fit");
static_assert((size_t)R * 512 * 2 + 32ull * S5N * S5K * 2 + (size_t)R * 512 * 2 <= (size_t)R * D * 2, "PD/UT/YG fit in H");

#define XB_TMO      128
#define XB_XCNT(j)  (256  + 64 * (j))
#define XB_XSUB(j)  (1280 + 64 * (j))
#define XB_XGEN(j)  (2304 + 64 * (j))
#define XB_TOP      3328
#define XB_TOPGEN   3392
#define XCD_BAR_WORDS 3456
#define XB_SPIN_CAP (1u << 20)
#define LAS __attribute__((address_space(3)))
__device__ __forceinline__ unsigned xb_ld(unsigned* p)              { return __hip_atomic_load(p, __ATOMIC_RELAXED, __HIP_MEMORY_SCOPE_AGENT); }
__device__ __forceinline__ unsigned xb_add(unsigned* p, unsigned v) { return __hip_atomic_fetch_add(p, v, __ATOMIC_RELAXED, __HIP_MEMORY_SCOPE_AGENT); }
__device__ __forceinline__ unsigned xb_xcc_id() { return (unsigned)__builtin_amdgcn_s_getreg((3 << 11) | 20) & 0xFu; }
#define XB_SPIN(cond, bar) do { unsigned _sp = 0; while (cond) { __builtin_amdgcn_s_sleep(1); \
    if ((++_sp & 255u) == 0u) { if (xb_ld(&(bar)[XB_TMO])) break; if (_sp > XB_SPIN_CAP) { atomicAdd(&(bar)[XB_TMO], 1u); break; } } } } while (0)
struct XcdBarrier { unsigned* bar; unsigned x; volatile LAS unsigned* st; };
__device__ __forceinline__ XcdBarrier xcd_barrier_post(unsigned* bar, volatile LAS unsigned* st) {
    XcdBarrier b; b.bar = bar; b.x = xb_xcc_id(); b.st = st;
    if (threadIdx.x == 0) (void)xb_add(&bar[XB_XCNT(b.x)], 1u);
    return b;
}
__device__ __forceinline__ void xcd_barrier_complete(unsigned* bar, unsigned x, unsigned& nloc, unsigned& nx) {
    const unsigned G = gridDim.x * gridDim.y * gridDim.z;
    unsigned sum, cnt, mine, sp = 0u;
    for (;;) {
        sum = 0u; cnt = 0u; mine = 0u;
#pragma unroll
        for (unsigned j = 0; j < 16; ++j) { const unsigned c = xb_ld(&bar[XB_XCNT(j)]); sum += c; cnt += (c > 0u) ? 1u : 0u; mine = (j == x) ? c : mine; }
        if (sum == G) break;
        __builtin_amdgcn_s_sleep(1);
        if ((++sp & 255u) == 0u) { if (xb_ld(&bar[XB_TMO])) break; if (sp > XB_SPIN_CAP) { atomicAdd(&bar[XB_TMO], 1u); break; } }
    }
    nloc = mine > 0u ? mine : 1u; nx = cnt > 0u ? cnt : 1u;
}
__device__ __forceinline__ void xcd_barrier(const XcdBarrier& b) {
    asm volatile("s_waitcnt vmcnt(0)" ::: "memory");
    __syncthreads();
    if (threadIdx.x == 0) {
        unsigned* bar = b.bar;
        __builtin_amdgcn_s_waitcnt(0);
        unsigned nloc = b.st[0], nx = b.st[1];
        if (nloc == 0u) { xcd_barrier_complete(bar, b.x, nloc, nx); b.st[0] = nloc; b.st[1] = nx; }
        const unsigned old = xb_add(&bar[XB_XSUB(b.x)], 1u);
        const unsigned gen = old / nloc;
        if (old + 1u == (gen + 1u) * nloc) {
            __builtin_amdgcn_fence(__ATOMIC_RELEASE, "agent");
            asm volatile("s_waitcnt vmcnt(0)" ::: "memory");
            const unsigned og = xb_add(&bar[XB_TOP], 1u);
            const unsigned tg = og / nx;
            if (og + 1u == (tg + 1u) * nx) xb_add(&bar[XB_TOPGEN], 1u);
            else XB_SPIN(xb_ld(&bar[XB_TOPGEN]) == tg, bar);
            __builtin_amdgcn_fence(__ATOMIC_ACQUIRE, "agent");
            xb_add(&bar[XB_XGEN(b.x)], 1u);
            asm volatile("s_waitcnt vmcnt(0)" ::: "memory");
        } else {
            XB_SPIN(xb_ld(&bar[XB_XGEN(b.x)]) == gen, bar);
            __builtin_amdgcn_fence(__ATOMIC_ACQUIRE, "agent");
            asm volatile("s_waitcnt vmcnt(0)" ::: "memory");
        }
    }
    __syncthreads();
}

__device__ __forceinline__ unsigned cvtpk(float lo, float hi) { unsigned r; asm("v_cvt_pk_bf16_f32 %0, %1, %2" : "=v"(r) : "v"(lo), "v"(hi)); return r; }
__device__ __forceinline__ float bflo(unsigned u) { return __uint_as_float(u << 16); }
__device__ __forceinline__ float bfhi(unsigned u) { return __uint_as_float(u & 0xffff0000u); }
__device__ __forceinline__ float sigmoidf_(float x) { return __builtin_amdgcn_rcpf(1.f + __builtin_amdgcn_exp2f(-1.4426950408889634f * x)); }
__device__ __forceinline__ float gelu_tanh(float x) { const float u = 0.7978845608028654f * (x + 0.044715f * x * x * x); return x * __builtin_amdgcn_rcpf(1.f + __builtin_amdgcn_exp2f(-2.885390081777927f * u)); }
__device__ __forceinline__ float dot2bf(unsigned a, unsigned b, float c) { return __builtin_amdgcn_fdot2_f32_bf16(__builtin_bit_cast(bf16x2v, a), __builtin_bit_cast(bf16x2v, b), c, false); }
__device__ __forceinline__ unsigned pack4f8(float a, float b, float c, float d) { int x = __builtin_amdgcn_cvt_pk_fp8_f32(a, b, 0, false); x = __builtin_amdgcn_cvt_pk_fp8_f32(c, d, x, true); return (unsigned)x; }
__device__ __forceinline__ uint2 pack4(f32x4 v) { uint2 r; r.x = cvtpk(v[0], v[1]); r.y = cvtpk(v[2], v[3]); return r; }
__device__ __forceinline__ f32x4 unpack4(uint2 u) { f32x4 r; r[0] = bflo(u.x); r[1] = bfhi(u.x); r[2] = bflo(u.y); r[3] = bfhi(u.y); return r; }

__device__ __forceinline__ int otid() { int t = threadIdx.x; asm volatile("" : "+v"(t)); return t; }
#define PH_TID const int tid = otid(), lane = tid & 63, wave = tid >> 6; (void)lane; (void)wave;

struct Params {
    const float* in[34];
    float* out;
    unsigned char* ws;
    int ph_lo, ph_hi;
};

__device__ __forceinline__ const float* pin(int i) {
    const __attribute__((address_space(4))) char* kp = (const __attribute__((address_space(4))) char*)__builtin_amdgcn_kernarg_segment_ptr();
    asm volatile("" : "+s"(kp));
    return *(const float* const __attribute__((address_space(4)))*)(kp + i * 8);
}

constexpr int BK = 64, HALF = 128, HT = HALF * BK;
__device__ __forceinline__ int lds_byte(int r, int c) {
    int st = (r >> 4) * 2 + (c >> 5), rr = r & 15, cc = c & 31, ob = rr * 64 + cc * 2;
    return st * 1024 + (ob ^ (((ob >> 9) & 1) << 5));
}
__device__ __forceinline__ void stage_rc(int b, int& Rr, int& Cc) {
    int st = b / 1024, sb = b % 1024, swz = sb ^ (((sb >> 9) & 1) << 5);
    Rr = (st >> 1) * 16 + swz / 64; Cc = (st & 1) * 32 + (swz % 64) / 2;
}
typedef f32x4 Acc[2][2][4][2];
#define EPI_LOOP for (int ai = 0; ai < 2; ++ai) for (int bj = 0; bj < 2; ++bj) for (int m = 0; m < 4; ++m) for (int n = 0; n < 2; ++n)

template <int F8, class Epi>
__device__ __forceinline__ void gemm_tile_acc(const u16* __restrict__ Pm, int ldp, const u16* __restrict__ Qm, int ldq, int K, u16* shm, Acc& acc, Epi& epi) {
#define SA(b, h) (shm + ((b) * 2 + (h)) * HT)
#define SB(b, h) (shm + (4 + (b) * 2 + (h)) * HT)
#define STAGE_X(T, PP, BASE, LD, VOFF, br, kt) do { const char* _g = (const char*)(BASE) + ((size_t)(br) * (LD) + (size_t)(kt) * BK) * 2; \
      __builtin_amdgcn_global_load_lds((const unsigned*)(_g + (VOFF)), (unsigned*)((char*)(PP) + (T) * 16), 16, 0, 0); \
      __builtin_amdgcn_global_load_lds((const unsigned*)(_g + (size_t)(LD) * 128 + (VOFF)), (unsigned*)((char*)(PP) + (T) * 16 + 8192), 16, 0, 0); } while (0)
#define STAGE_A(PP, br, kt) STAGE_X(t0_, PP, Pm, ldp, voffA, br, kt)
#define STAGE_B(PP, br, kt) STAGE_X(t0_, PP, Qm, ldq, voffB, br, kt)
#define LDA(dst, b, h) for (int m = 0; m < 4; ++m) \
    dst[m] = __builtin_shufflevector(*reinterpret_cast<const v4i*>((char*)SA(b, h) + lds_byte(wr * 64 + m * 16 + fr, fq * 8)), \
                                     *reinterpret_cast<const v4i*>((char*)SA(b, h) + lds_byte(wr * 64 + m * 16 + fr, 32 + fq * 8)), 0, 1, 2, 3, 4, 5, 6, 7)
#define LDB(dst, b, h) for (int n = 0; n < 2; ++n) \
    dst[n] = __builtin_shufflevector(*reinterpret_cast<const v4i*>((char*)SB(b, h) + lds_byte(wc * 32 + n * 16 + fr, fq * 8)), \
                                     *reinterpret_cast<const v4i*>((char*)SB(b, h) + lds_byte(wc * 32 + n * 16 + fr, 32 + fq * 8)), 0, 1, 2, 3, 4, 5, 6, 7)
#define FLO(x) __builtin_bit_cast(bf16x8, __builtin_shufflevector(x, x, 0, 1, 2, 3))
#define FHI(x) __builtin_bit_cast(bf16x8, __builtin_shufflevector(x, x, 4, 5, 6, 7))
#define MMA(ai, bj, At, Bt) do { __builtin_amdgcn_s_setprio(1); \
    if (F8 == 1) { for (int m = 0; m < 4; ++m) for (int n = 0; n < 2; ++n) \
      asm("v_mfma_f32_16x16x128_f8f6f4 %0, %1, %2, %0" : "+v"(acc[ai][bj][m][n]) : "v"(At[m]), "v"(Bt[n])); } \
    else if (F8 == 2) { for (int m = 0; m < 4; ++m) for (int n = 0; n < 2; ++n) \
      asm("v_mfma_f32_16x16x128_f8f6f4 %0, %1, %2, %0 cbsz:4 blgp:4" : "+v"(acc[ai][bj][m][n]) : "v"(__builtin_shufflevector(At[m], At[m], 0, 1, 2, 3)), "v"(__builtin_shufflevector(Bt[n], Bt[n], 0, 1, 2, 3))); \
      for (int m = 0; m < 4; ++m) for (int n = 0; n < 2; ++n) \
      asm("v_mfma_f32_16x16x128_f8f6f4 %0, %1, %2, %0 cbsz:4 blgp:4" : "+v"(acc[ai][bj][m][n]) : "v"(__builtin_shufflevector(At[m], At[m], 4, 5, 6, 7)), "v"(__builtin_shufflevector(Bt[n], Bt[n], 4, 5, 6, 7))); } \
    else { for (int m = 0; m < 4; ++m) for (int n = 0; n < 2; ++n) { \
      acc[ai][bj][m][n] = __builtin_amdgcn_mfma_f32_16x16x32_bf16(FLO(At[m]), FLO(Bt[n]), acc[ai][bj][m][n], 0, 0, 0); \
      acc[ai][bj][m][n] = __builtin_amdgcn_mfma_f32_16x16x32_bf16(FHI(At[m]), FHI(Bt[n]), acc[ai][bj][m][n], 0, 0, 0); } } \
    __builtin_amdgcn_s_setprio(0); } while (0)
#define WAIT_V(n) asm volatile("s_waitcnt vmcnt(" #n ")" ::: "memory")
#define WAIT_L(n) asm volatile("s_waitcnt lgkmcnt(" #n ")" ::: "memory")
#define BAR __builtin_amdgcn_s_barrier()
#define SCHED __builtin_amdgcn_sched_barrier(0)
    const int t0_ = otid();
    int wid = t0_ >> 6, lane = t0_ & 63, wr = wid >> 2, wc = wid & 3, fr = lane & 15, fq = lane >> 4;
    unsigned voffA, voffB;
    { int _r, _c; stage_rc(t0_ * 16, _r, _c); voffA = (unsigned)(_r * ldp + _c) * 2u; voffB = (unsigned)(_r * ldq + _c) * 2u; }
    v8i At[4], B0[2], B1[2];
    const int nt = K / BK;
    STAGE_B(SB(0, 0), 0, 0); STAGE_A(SA(0, 0), 0, 0);
    STAGE_B(SB(0, 1), HALF, 0); STAGE_A(SA(0, 1), HALF, 0);
    if (wr == 1) BAR;
    WAIT_V(4); BAR;
    STAGE_B(SB(1, 0), 0, 1); STAGE_A(SA(1, 0), 0, 1); STAGE_B(SB(1, 1), HALF, 1);
    WAIT_V(6); BAR;
    for (int t = 0; t < nt - 2; t += 2) {
        LDB(B0, 0, 0); SCHED; LDA(At, 0, 0); STAGE_A(SA(1, 1), HALF, t + 1);
        WAIT_L(8); BAR; WAIT_L(0); MMA(0, 0, At, B0); BAR; SCHED;
        LDB(B1, 0, 1); STAGE_B(SB(0, 0), 0, t + 2);
        BAR; WAIT_L(0); MMA(0, 1, At, B1); BAR;
        LDA(At, 0, 1); STAGE_A(SA(0, 0), 0, t + 2);
        BAR; WAIT_L(0); MMA(1, 0, At, B0); BAR; SCHED;
        STAGE_B(SB(0, 1), HALF, t + 2);
        WAIT_V(6); BAR; MMA(1, 1, At, B1); BAR;
        LDB(B0, 1, 0); SCHED; LDA(At, 1, 0); STAGE_A(SA(0, 1), HALF, t + 2);
        WAIT_L(8); BAR; WAIT_L(0); MMA(0, 0, At, B0); BAR; SCHED;
        LDB(B1, 1, 1); STAGE_B(SB(1, 0), 0, t + 3);
        BAR; WAIT_L(0); MMA(0, 1, At, B1); BAR;
        LDA(At, 1, 1); STAGE_A(SA(1, 0), 0, t + 3);
        BAR; WAIT_L(0); MMA(1, 0, At, B0); BAR; SCHED;
        STAGE_B(SB(1, 1), HALF, t + 3);
        WAIT_V(6); BAR; MMA(1, 1, At, B1); BAR;
    }
    int tz = threadIdx.x; asm volatile("" : "+v"(tz)); wid = tz >> 6; lane = tz & 63; wr = wid >> 2; wc = wid & 3; fr = lane & 15; fq = lane >> 4;
    { int _r, _c; stage_rc(tz * 16, _r, _c); voffA = (unsigned)(_r * ldp + _c) * 2u; }
    { LDB(B0, 0, 0); WAIT_V(0); LDA(At, 0, 0); STAGE_X(tz, SA(1, 1), Pm, ldp, voffA, HALF, nt - 1);
      BAR; WAIT_L(0); MMA(0, 0, At, B0); BAR;
      LDB(B1, 0, 1); BAR; WAIT_L(0); MMA(0, 1, At, B1); BAR;
      LDA(At, 0, 1); WAIT_V(4); BAR; WAIT_L(0); MMA(1, 0, At, B0); MMA(1, 1, At, B1); BAR; }
    { LDB(B0, 1, 0); LDA(At, 1, 0); WAIT_V(2); BAR; WAIT_L(0); MMA(0, 0, At, B0); BAR;
      LDB(B1, 1, 1); WAIT_V(0); BAR; WAIT_L(0); MMA(0, 1, At, B1); BAR;
      LDA(At, 1, 1); BAR; WAIT_L(0); MMA(1, 0, At, B0); MMA(1, 1, At, B1); BAR; }
    if (wr == 0) BAR;
    if (F8) asm volatile("s_nop 7\n\ts_nop 7\n\ts_nop 7" ::: "memory");
    epi(acc, wr, wc, fr, fq);
    __syncthreads();
#undef SA
#undef SB
#undef STAGE_X
#undef STAGE_A
#undef STAGE_B
#undef LDA
#undef LDB
#undef MMA
#undef FLO
#undef FHI
}
template <int F8, class Epi>
__device__ __forceinline__ void gemm_tile(const u16* __restrict__ Pm, int ldp, const u16* __restrict__ Qm, int ldq, int K, u16* shm, Epi& epi) {
    Acc acc = {}; gemm_tile_acc<F8>(Pm, ldp, Qm, ldq, K, shm, acc, epi);
}
#define EPI_LOFF(ld, es) ((unsigned)(((wc * 32 + fr) * (ld) + wr * 64 + fq * 4) * (es)))
#define EPI_UOFF(ld, es) ((size_t)(((bj * 128 + n * 16) * (ld) + ai * 128 + m * 16) * (es)))
#define EPI_ILOFF(es) ((unsigned)((wr * 64 + fq * 4) * (es)))
#define EPI_IUOFF(es) ((size_t)((ai * 128 + m * 16) * (es)))
#define TR4(p0, p1, p2, p3) do { \
        { const auto x_ = __builtin_amdgcn_permlane32_swap(p0, p2, false, false); p0 = x_[0]; p2 = x_[1]; } \
        { const auto x_ = __builtin_amdgcn_permlane32_swap(p1, p3, false, false); p1 = x_[0]; p3 = x_[1]; } \
        { const auto x_ = __builtin_amdgcn_permlane16_swap(p0, p1, false, false); p0 = x_[0]; p1 = x_[1]; } \
        { const auto x_ = __builtin_amdgcn_permlane16_swap(p2, p3, false, false); p2 = x_[0]; p3 = x_[1]; } } while (0)
#define EPI_LOOP3 for (int ai = 0; ai < 2; ++ai) for (int bj = 0; bj < 2; ++bj) for (int n = 0; n < 2; ++n)
#define EPI_UOFF3(ld, es) ((size_t)(((bj * 128 + n * 16) * (ld) + ai * 128) * (es)))
#define EPI_LOFF16(ld, es) ((unsigned)(((wc * 32 + fr) * (ld) + wr * 64 + fq * 16) * (es)))
#define ST16x2(ptr, q0, q1, q2, q3) do { unsigned l0_ = (q0).x, l1_ = (q1).x, l2_ = (q2).x, l3_ = (q3).x, h0_ = (q0).y, h1_ = (q1).y, h2_ = (q2).y, h3_ = (q3).y; \
        TR4(l0_, l1_, l2_, l3_); TR4(h0_, h1_, h2_, h3_); \
        *(u32x4*)(ptr) = (u32x4){l0_, h0_, l1_, h1_}; *(u32x4*)((char*)(ptr) + 16) = (u32x4){l2_, h2_, l3_, h3_}; } while (0)
#define LD16x2(ptr, q0, q1, q2, q3) do { const u32x4 A_ = *(const u32x4*)(ptr), B_ = *(const u32x4*)((const char*)(ptr) + 16); \
        unsigned l0_ = A_[0], h0_ = A_[1], l1_ = A_[2], h1_ = A_[3], l2_ = B_[0], h2_ = B_[1], l3_ = B_[2], h3_ = B_[3]; \
        TR4(l0_, l1_, l2_, l3_); TR4(h0_, h1_, h2_, h3_); \
        (q0).x = l0_; (q0).y = h0_; (q1).x = l1_; (q1).y = h1_; (q2).x = l2_; (q2).y = h2_; (q3).x = l3_; (q3).y = h3_; } while (0)

struct EpiG1 {
    int kind;
    void* out; int ldo;
    bool lat; int t0;
    const float2* rope; float qscale; float wsc;
    __device__ __forceinline__ void operator()(Acc& acc, int wr, int wc, int fr, int fq) {
        const bool f8 = (kind != 0);
        const unsigned loff = f8 ? EPI_LOFF(ldo, 1) : EPI_LOFF(ldo, 2);
#pragma unroll
        for (int bj = 0; bj < 2; ++bj)
#pragma unroll
        for (int n = 0; n < 2; ++n) {
            const int j = bj * 128 + wc * 32 + n * 16 + fr;
            const int t = t0 + j, pr = t >> 6, pc = t & 63;
#pragma unroll
            for (int ai = 0; ai < 2; ++ai) {
                f32x4 v0 = acc[ai][bj][0][n] * wsc, v1 = acc[ai][bj][1][n] * wsc, v2 = acc[ai][bj][2][n] * wsc, v3 = acc[ai][bj][3][n] * wsc;
                if ((kind == 1 || kind == 2) && lat) {
#pragma unroll
                    for (int e = 0; e < 4; ++e) {
                        const float2 cr = rope[pr * 16 + fq * 4 + e], cc = rope[pc * 16 + fq * 4 + e];
                        const float a1 = v0[e], a2 = v1[e], b1 = v2[e], b2 = v3[e];
                        v0[e] = a1 * cr.x - a2 * cr.y; v1[e] = a1 * cr.y + a2 * cr.x;
                        v2[e] = b1 * cc.x - b2 * cc.y; v3[e] = b1 * cc.y + b2 * cc.x;
                    }
                }
                if (kind == 3) {
                    const float c1 = -1.4426950408889634f * wsc, c0 = 0.0078125f;
#pragma unroll
                    for (int e = 0; e < 4; ++e) {
                        v0[e] = __builtin_amdgcn_rcpf(c0 + __builtin_amdgcn_exp2f(__builtin_fmaf(acc[ai][bj][0][n][e], c1, -7.f)));
                        v1[e] = __builtin_amdgcn_rcpf(c0 + __builtin_amdgcn_exp2f(__builtin_fmaf(acc[ai][bj][1][n][e], c1, -7.f)));
                        v2[e] = __builtin_amdgcn_rcpf(c0 + __builtin_amdgcn_exp2f(__builtin_fmaf(acc[ai][bj][2][n][e], c1, -7.f)));
                        v3[e] = __builtin_amdgcn_rcpf(c0 + __builtin_amdgcn_exp2f(__builtin_fmaf(acc[ai][bj][3][n][e], c1, -7.f)));
                    }
                }
                if (f8) {
                    if (kind != 3) { v0 *= qscale; v1 *= qscale; v2 *= qscale; v3 *= qscale; }
                    unsigned p0 = pack4f8(v0[0], v0[1], v0[2], v0[3]), p1 = pack4f8(v1[0], v1[1], v1[2], v1[3]), p2 = pack4f8(v2[0], v2[1], v2[2], v2[3]), p3 = pack4f8(v3[0], v3[1], v3[2], v3[3]);
                    TR4(p0, p1, p2, p3);
                    char* o = (char*)out + (size_t)((bj * 128 + n * 16) * ldo + ai * 128) + loff + fq * 12;
                    *(u32x4*)o = (u32x4){p0, p1, p2, p3};
                } else {
                    char* o = (char*)out + (size_t)(((bj * 128 + n * 16) * ldo + ai * 128) * 2) + loff + fq * 24;
                    const uint2 q0 = pack4(v0), q1 = pack4(v1), q2 = pack4(v2), q3 = pack4(v3);
                    ST16x2(o, q0, q1, q2, q3);
                }
            }
        }
    }
};
struct EpiV {
    unsigned char* vt;
    __device__ __forceinline__ void operator()(Acc& acc, int wr, int wc, int fr, int fq) {
        const unsigned loff = EPI_LOFF16(SK, 1);
#pragma unroll
        EPI_LOOP3 { const f32x4 v0 = acc[ai][bj][0][n] * (1.f / 32.f), v1 = acc[ai][bj][1][n] * (1.f / 32.f), v2 = acc[ai][bj][2][n] * (1.f / 32.f), v3 = acc[ai][bj][3][n] * (1.f / 32.f);
            unsigned p0 = pack4f8(v0[0], v0[1], v0[2], v0[3]), p1 = pack4f8(v1[0], v1[1], v1[2], v1[3]), p2 = pack4f8(v2[0], v2[1], v2[2], v2[3]), p3 = pack4f8(v3[0], v3[1], v3[2], v3[3]);
            TR4(p0, p1, p2, p3);
            *(u32x4*)((char*)vt + EPI_UOFF3(SK, 1) + loff) = (u32x4){p0, p1, p2, p3}; }
    }
};
struct EpiStoreF8 {
    unsigned char* out; float sc;
    __device__ __forceinline__ void operator()(Acc& acc, int wr, int wc, int fr, int fq) {
        const unsigned loff = EPI_LOFF16(2048, 1);
#pragma unroll
        EPI_LOOP3 { const f32x4 v0 = acc[ai][bj][0][n] * sc, v1 = acc[ai][bj][1][n] * sc, v2 = acc[ai][bj][2][n] * sc, v3 = acc[ai][bj][3][n] * sc;
            unsigned p0 = pack4f8(v0[0], v0[1], v0[2], v0[3]), p1 = pack4f8(v1[0], v1[1], v1[2], v1[3]), p2 = pack4f8(v2[0], v2[1], v2[2], v2[3]), p3 = pack4f8(v3[0], v3[1], v3[2], v3[3]);
            TR4(p0, p1, p2, p3);
            *(u32x4*)((char*)out + EPI_UOFF3(2048, 1) + loff) = (u32x4){p0, p1, p2, p3}; }
    }
};
struct EpiPool {
    unsigned char* out; const float* scale;
    __device__ __forceinline__ void operator()(Acc& acc, int wr, int wc, int fr, int fq) {
        const unsigned loff = EPI_LOFF(512, 1), iloff = EPI_ILOFF(4);
#pragma unroll
        EPI_LOOP3 { unsigned pk[4];
#pragma unroll
            for (int m = 0; m < 4; ++m) { const f32x4 s = *(const f32x4*)((const char*)scale + EPI_IUOFF(4) + iloff); const f32x4 v = acc[ai][bj][m][n] * s * 4.f; pk[m] = pack4f8(v[0], v[1], v[2], v[3]); }
            unsigned p0 = pk[0], p1 = pk[1], p2 = pk[2], p3 = pk[3];
            TR4(p0, p1, p2, p3);
            *(u32x4*)((char*)out + EPI_UOFF3(512, 1) + loff + fq * 12) = (u32x4){p0, p1, p2, p3}; }
    }
};
struct EpiS5E {
    float* out;
    __device__ __forceinline__ void operator()(Acc& acc, int wr, int wc, int fr, int fq) {
        const unsigned loff = EPI_LOFF(256, 4);
#pragma unroll
        EPI_LOOP { *(f32x4*)((char*)out + EPI_UOFF(256, 4) + loff) = acc[ai][bj][m][n]; }
    }
};
struct EpiS5Y {
    u16* yg; int g, it, nt;
    __device__ __forceinline__ void operator()(Acc& acc, int wr, int wc, int fr, int fq) {
        if (nt < 4) {
            const unsigned loff = (unsigned)(((((wc * 32 + fr) * S5L + wr * 4) * 512) + fq * 4) * 2);
#pragma unroll
            EPI_LOOP { f32x4 v = acc[ai][bj][m][n];
#pragma unroll
                for (int e = 0; e < 4; ++e) v[e] = gelu_tanh(v[e]);
                const size_t uo = ((size_t)((nt * 2 + bj) * SEQ + n * 16 * S5L + it * 16 + ai * 8 + m) * 512 + g * 16) * 2;
                *(uint2*)((char*)yg + uo + loff) = pack4(v); }
        } else {
            if (wc < 2) {
                const unsigned loff = (unsigned)(((((wc * 4 + (fr >> 3)) * CTXL + (fr & 7) * S5L + wr * 4) * 512) + fq * 4) * 2);
#pragma unroll
                for (int ai = 0; ai < 2; ++ai)
#pragma unroll
                for (int m = 0; m < 4; ++m)
#pragma unroll
                for (int n = 0; n < 2; ++n) { f32x4 v = acc[ai][0][m][n];
#pragma unroll
                    for (int e = 0; e < 4; ++e) v[e] = gelu_tanh(v[e]);
                    const size_t uo = ((size_t)(RL + n * 2 * CTXL + it * 16 + ai * 8 + m) * 512 + g * 16) * 2;
                    *(uint2*)((char*)yg + uo + loff) = pack4(v); }
            }
        }
    }
};
struct EpiGlu {
    unsigned char* out; const u16* yg;
    __device__ __forceinline__ void operator()(Acc& acc, int wr, int wc, int fr, int fq) {
        const unsigned loff = EPI_LOFF(512, 2), loff1 = EPI_LOFF(512, 1);
#pragma unroll
        EPI_LOOP3 { uint2 g4[4]; LD16x2((const char*)yg + EPI_UOFF3(512, 2) + loff + fq * 24, g4[0], g4[1], g4[2], g4[3]);
            unsigned pk[4];
#pragma unroll
            for (int m = 0; m < 4; ++m) { const f32x4 gg = unpack4(g4[m]); f32x4 v = acc[ai][bj][m][n];
#pragma unroll
                for (int e = 0; e < 4; ++e) v[e] = 4.f * gg[e] * sigmoidf_(v[e]);
                pk[m] = pack4f8(v[0], v[1], v[2], v[3]); }
            unsigned p0 = pk[0], p1 = pk[1], p2 = pk[2], p3 = pk[3];
            TR4(p0, p1, p2, p3);
            *(u32x4*)((char*)out + EPI_UOFF3(512, 1) + loff1 + fq * 12) = (u32x4){p0, p1, p2, p3}; }
    }
};
struct EpiMerge {
    unsigned char* mrg8; const unsigned char* gate; int br;
    __device__ __forceinline__ void operator()(Acc& acc, int wr, int wc, int fr, int fq) {
        const unsigned loffg = EPI_LOFF(6144, 1), loff8 = EPI_LOFF(2048, 1);
        const float GE = 0.0009765625f;
        const bool more = br < 2; const unsigned char* gnext = more ? gate + 2048 : gate;
#pragma unroll
        for (int ai = 0; ai < 2; ++ai) {
#pragma unroll
            for (int bj = 0; bj < 2; ++bj)
#pragma unroll
            for (int n = 0; n < 2; ++n) {
                const size_t uo = (size_t)((bj * 128 + n * 16) * 6144 + ai * 128);
                const u32x4 qa = *(const u32x4*)((const char*)gate + uo + loffg + fq * 12), qb = *(const u32x4*)((const char*)gnext + uo + loffg + fq * 12);
                unsigned a0 = qa[0], a1 = qa[1], a2 = qa[2], a3 = qa[3], b0 = qb[0], b1 = qb[1], b2 = qb[2], b3 = qb[3];
                TR4(a0, a1, a2, a3); TR4(b0, b1, b2, b3);
#pragma unroll
                for (int m = 0; m < 4; ++m) {
                    const int ga = (int)((m == 0) ? a0 : (m == 1) ? a1 : (m == 2) ? a2 : a3), gb = (int)((m == 0) ? b0 : (m == 1) ? b1 : (m == 2) ? b2 : b3);
                    const f32x2 a01 = __builtin_amdgcn_cvt_pk_f32_fp8(ga, false), a23 = __builtin_amdgcn_cvt_pk_f32_fp8(ga, true);
                    const f32x2 b01 = __builtin_amdgcn_cvt_pk_f32_fp8(gb, false), b23 = __builtin_amdgcn_cvt_pk_f32_fp8(gb, true);
                    const float r0 = more ? __builtin_amdgcn_rcpf(b01[0] + GE) : (4.f / (64.f * 128.f)), r1 = more ? __builtin_amdgcn_rcpf(b01[1] + GE) : (4.f / (64.f * 128.f));
                    const float r2 = more ? __builtin_amdgcn_rcpf(b23[0] + GE) : (4.f / (64.f * 128.f)), r3 = more ? __builtin_amdgcn_rcpf(b23[1] + GE) : (4.f / (64.f * 128.f));
                    acc[ai][bj][m][n] *= (f32x4){(a01[0] + GE) * r0, (a01[1] + GE) * r1, (a23[0] + GE) * r2, (a23[1] + GE) * r3}; }
            }
            __builtin_amdgcn_sched_barrier(0); }
        if (!more) {
#pragma unroll
            for (int ai = 0; ai < 2; ++ai)
#pragma unroll
            for (int bj = 0; bj < 2; ++bj)
#pragma unroll
            for (int n = 0; n < 2; ++n) {
                const f32x4 v0 = acc[ai][bj][0][n], v1 = acc[ai][bj][1][n], v2 = acc[ai][bj][2][n], v3 = acc[ai][bj][3][n];
                unsigned p0 = pack4f8(v0[0], v0[1], v0[2], v0[3]), p1 = pack4f8(v1[0], v1[1], v1[2], v1[3]), p2 = pack4f8(v2[0], v2[1], v2[2], v2[3]), p3 = pack4f8(v3[0], v3[1], v3[2], v3[3]);
                TR4(p0, p1, p2, p3);
                *(u32x4*)((char*)mrg8 + (size_t)((bj * 128 + n * 16) * 2048 + ai * 128) + loff8 + fq * 12) = (u32x4){p0, p1, p2, p3};
            }
        }
    }
};
struct EpiRes {
    const void* xin; void* xout; const float* gate; float sc; bool in16, out16;
    __device__ __forceinline__ void operator()(Acc& acc, int wr, int wc, int fr, int fq) {
        const unsigned loff4 = EPI_LOFF(2048, 4), loff2 = EPI_LOFF(2048, 2), iloff = EPI_ILOFF(4);
#pragma unroll
        EPI_LOOP3 { uint2 xi[4], yo[4];
            if (in16) LD16x2((const char*)xin + EPI_UOFF3(2048, 2) + loff2 + fq * 24, xi[0], xi[1], xi[2], xi[3]);
#pragma unroll
            for (int m = 0; m < 4; ++m) { const f32x4 gg = *(const f32x4*)((const char*)gate + EPI_IUOFF(4) + iloff);
                f32x4 x;
                if (in16) x = unpack4(xi[m]); else x = *(const f32x4*)((const char*)xin + EPI_UOFF(2048, 4) + loff4);
                const f32x4 y = x + gg * acc[ai][bj][m][n] * sc;
                if (out16) yo[m] = pack4(y); else *(f32x4*)((char*)xout + EPI_UOFF(2048, 4) + loff4) = y; }
            if (out16) ST16x2((char*)xout + EPI_UOFF3(2048, 2) + loff2 + fq * 24, yo[0], yo[1], yo[2], yo[3]); }
    }
};
struct EpiF16 {
    _Float16* out; float sc;
    __device__ __forceinline__ void operator()(Acc& acc, int wr, int wc, int fr, int fq) {
        const unsigned loff = EPI_LOFF(2048, 2);
#pragma unroll
        EPI_LOOP3 { uint2 pk[4];
#pragma unroll
            for (int m = 0; m < 4; ++m) { const f32x4 v = acc[ai][bj][m][n] * sc; const h16x2 lo = (h16x2){(_Float16)v[0], (_Float16)v[1]}, hi = (h16x2){(_Float16)v[2], (_Float16)v[3]};
                pk[m].x = __builtin_bit_cast(unsigned, lo); pk[m].y = __builtin_bit_cast(unsigned, hi); }
            ST16x2((char*)out + EPI_UOFF3(2048, 2) + loff + fq * 24, pk[0], pk[1], pk[2], pk[3]); }
    }
};

__device__ __forceinline__ void transpose_item(const float* src, long lds_, u16* dst, long ldd, int k0, int n0, u16* scr, int lane) {
#pragma unroll 4
    for (int it = 0; it < 16; ++it) {
        const int r = it * 4 + (lane >> 4), c = (lane & 15) * 4;
        const float4 v = *(const float4*)(src + (long)(k0 + r) * lds_ + n0 + c);
        scr[(c + 0) * 72 + r] = (u16)(cvtpk(v.x, 0.f) & 0xffff); scr[(c + 1) * 72 + r] = (u16)(cvtpk(v.y, 0.f) & 0xffff);
        scr[(c + 2) * 72 + r] = (u16)(cvtpk(v.z, 0.f) & 0xffff); scr[(c + 3) * 72 + r] = (u16)(cvtpk(v.w, 0.f) & 0xffff);
    }
    __builtin_amdgcn_s_waitcnt(0xc07f);
    __builtin_amdgcn_wave_barrier();
#pragma unroll 4
    for (int it = 0; it < 8; ++it) {
        const int id = it * 64 + lane, nn = id >> 3, ch = id & 7;
        const uint4 v = *(const uint4*)(scr + nn * 72 + ch * 8);
        *(uint4*)(dst + (long)(n0 + nn) * ldd + k0 + ch * 8) = v;
    }
    __builtin_amdgcn_s_waitcnt(0xc07f);
    __builtin_amdgcn_wave_barrier();
}

__device__ __forceinline__ void transpose_item4(const float* src, long lds_, unsigned char* dst4, long ldd, int k0, int n0, unsigned char* scr, int lane, float scale) {
#pragma unroll 4
    for (int it = 0; it < 8; ++it) {
        const int r2 = it * 4 + (lane >> 4), c = (lane & 15) * 4;
        const float4 v0 = *(const float4*)(src + (long)(k0 + 2 * r2) * lds_ + n0 + c), v1 = *(const float4*)(src + (long)(k0 + 2 * r2 + 1) * lds_ + n0 + c);
        unsigned b = 0u;
        b = __builtin_amdgcn_cvt_scalef32_pk_fp4_f32(b, v0.x * scale, v1.x * scale, 1.0f, 0); b = __builtin_amdgcn_cvt_scalef32_pk_fp4_f32(b, v0.y * scale, v1.y * scale, 1.0f, 1);
        b = __builtin_amdgcn_cvt_scalef32_pk_fp4_f32(b, v0.z * scale, v1.z * scale, 1.0f, 2); b = __builtin_amdgcn_cvt_scalef32_pk_fp4_f32(b, v0.w * scale, v1.w * scale, 1.0f, 3);
        scr[(c + 0) * 48 + r2] = (unsigned char)(b & 0xff); scr[(c + 1) * 48 + r2] = (unsigned char)((b >> 8) & 0xff);
        scr[(c + 2) * 48 + r2] = (unsigned char)((b >> 16) & 0xff); scr[(c + 3) * 48 + r2] = (unsigned char)(b >> 24);
    }
    __builtin_amdgcn_s_waitcnt(0xc07f);
    __builtin_amdgcn_wave_barrier();
#pragma unroll
    for (int it = 0; it < 2; ++it) {
        const int id = it * 64 + lane, nn = id >> 1, ch = id & 1;
        const uint4 v = *(const uint4*)(scr + nn * 48 + ch * 16);
        *(uint4*)(dst4 + (long)(n0 + nn) * ldd + k0 / 2 + ch * 16) = v;
    }
    __builtin_amdgcn_s_waitcnt(0xc07f);
    __builtin_amdgcn_wave_barrier();
}
__device__ __forceinline__ void transpose_item8(const float* src, long lds_, unsigned char* dst, long ldd, int k0, int n0, unsigned char* scr, int lane, float scale) {
#pragma unroll 4
    for (int it = 0; it < 16; ++it) {
        const int r = it * 4 + (lane >> 4), c = (lane & 15) * 4;
        const float4 v = *(const float4*)(src + (long)(k0 + r) * lds_ + n0 + c);
        const unsigned pk = pack4f8(v.x * scale, v.y * scale, v.z * scale, v.w * scale);
        scr[(c + 0) * 80 + r] = (unsigned char)(pk & 0xff); scr[(c + 1) * 80 + r] = (unsigned char)((pk >> 8) & 0xff);
        scr[(c + 2) * 80 + r] = (unsigned char)((pk >> 16) & 0xff); scr[(c + 3) * 80 + r] = (unsigned char)(pk >> 24);
    }
    __builtin_amdgcn_s_waitcnt(0xc07f);
    __builtin_amdgcn_wave_barrier();
#pragma unroll
    for (int it = 0; it < 4; ++it) {
        const int id = it * 64 + lane, nn = id >> 2, ch = id & 3;
        const uint4 v = *(const uint4*)(scr + nn * 80 + ch * 16);
        *(uint4*)(dst + (long)(n0 + nn) * ldd + k0 + ch * 16) = v;
    }
    __builtin_amdgcn_s_waitcnt(0xc07f);
    __builtin_amdgcn_wave_barrier();
}

template <bool F8, bool IN16 = false>
__device__ __forceinline__ void rms_mod_row(const void* xr, const float* g, const float* shift, const float* scale, void* o, int lane, unsigned* o4 = nullptr, unsigned char* o8 = nullptr) {
    float4 v[8]; float ss = 0.f;
#pragma unroll
    for (int i = 0; i < 4; ++i) {
        if (IN16) { const u32x4 t = ((const u32x4*)xr)[lane + 64 * i]; const unsigned t0 = t[0], t1 = t[1], t2 = t[2], t3 = t[3];
            v[2 * i] = make_float4(bflo(t0), bfhi(t0), bflo(t1), bfhi(t1)); v[2 * i + 1] = make_float4(bflo(t2), bfhi(t2), bflo(t3), bfhi(t3)); }
        else { v[2 * i] = ((const float4*)xr)[(lane + 64 * i) * 2]; v[2 * i + 1] = ((const float4*)xr)[(lane + 64 * i) * 2 + 1]; }
    }
#pragma unroll
    for (int i = 0; i < 8; ++i) ss += v[i].x * v[i].x + v[i].y * v[i].y + v[i].z * v[i].z + v[i].w * v[i].w;
#pragma unroll
    for (int of = 32; of > 0; of >>= 1) ss += __shfl_xor(ss, of);
    const float inv = rsqrtf(ss * (1.f / 2048.f) + 1e-6f);
#pragma unroll
    for (int i = 0; i < 4; ++i) {
        unsigned pk[4], p8[2] = {0u, 0u};
#pragma unroll
        for (int h = 0; h < 2; ++h) {
            const int vi = (lane + 64 * i) * 2 + h;
            const float4 gg = ((const float4*)g)[vi], sh = ((const float4*)shift)[vi], sc = ((const float4*)scale)[vi]; const float4 x = v[2 * i + h];
            const float y0 = x.x * inv * gg.x * (1.f + sc.x) + sh.x, y1 = x.y * inv * gg.y * (1.f + sc.y) + sh.y;
            const float y2 = x.z * inv * gg.z * (1.f + sc.z) + sh.z, y3 = x.w * inv * gg.w * (1.f + sc.w) + sh.w;
            if (F8) { pk[h] = pack4f8(y0, y1, y2, y3);
                if (h == 0) { pk[2] = __builtin_amdgcn_cvt_scalef32_pk_fp4_f32(0u, y0 * G4_HS, y1 * G4_HS, 1.0f, 0); pk[2] = __builtin_amdgcn_cvt_scalef32_pk_fp4_f32(pk[2], y2 * G4_HS, y3 * G4_HS, 1.0f, 1); }
                else { pk[2] = __builtin_amdgcn_cvt_scalef32_pk_fp4_f32(pk[2], y0 * G4_HS, y1 * G4_HS, 1.0f, 2); pk[2] = __builtin_amdgcn_cvt_scalef32_pk_fp4_f32(pk[2], y2 * G4_HS, y3 * G4_HS, 1.0f, 3); } }
            else { pk[2 * h] = cvtpk(y0, y1); pk[2 * h + 1] = cvtpk(y2, y3); if (o8) p8[h] = pack4f8(y0, y1, y2, y3); }
        }
        if (!F8 && o8) { uint2 q2; q2.x = p8[0]; q2.y = p8[1]; ((uint2*)o8)[lane + 64 * i] = q2; }
        if (F8 && o4) o4[lane + 64 * i] = pk[2];
        if (F8) { uint2 p2; p2.x = pk[0]; p2.y = pk[1]; ((uint2*)o)[lane + 64 * i] = p2; }
        else ((u32x4*)o)[lane + 64 * i] = (u32x4){pk[0], pk[1], pk[2], pk[3]};
    }
}

__device__ __forceinline__ void s5_lampow(float ar, float ai, float dt, float n, float& re, float& im) {
    const float mag = expf(ar * dt * n); float s, c; sincosf(ai * dt * n, &s, &c); re = mag * c; im = mag * s;
}
__device__ __forceinline__ void s5_coef(float ar, float ai, float dt, float& cre, float& cim) {
    float lr, li; s5_lampow(ar, ai, dt, 1.f, lr, li);
    const float den = ar * ar + ai * ai;
    cre = ((lr - 1.f) * ar + li * ai) / den; cim = (li * ar - (lr - 1.f) * ai) / den;
}

constexpr int AROW = 144, AKBUF = 128 * AROW, AVBUF = 144 * AROW;
__device__ __forceinline__ void attn_prep(char* shm) {
    const int tid = otid();
    for (int i = tid; i < 2 * 16 * 36; i += 512) { const int bufi = i / 576, r = (i % 576) / 36, c = i % 36;
        *(unsigned*)(shm + 2 * AKBUF + bufi * AVBUF + (128 + r) * AROW + c * 4) = (r == 0) ? 0x38383838u : 0u; }
    __syncthreads();
}
__device__ __forceinline__ void attn_unit(const unsigned char* __restrict__ Q8, const unsigned char* __restrict__ K8, const unsigned char* __restrict__ Vt8, unsigned char* __restrict__ Yatt,
                                          int b, int hd, int qrow0, int kt_lo, int kt_hi, float lam, float post_scale, const float* __restrict__ subg, char* shm) {
    const int tid = otid(), wave = tid >> 6, lane = tid & 63, q = lane & 15, g4 = lane >> 4;
    char* kbuf = shm; char* vbuf = shm + 2 * AKBUF;
    const unsigned char* qp = Q8 + (long)(qrow0 + wave * 16 + q) * 1024 + hd * 128;
    long qf[2][2];
#pragma unroll
    for (int c = 0; c < 2; ++c)
#pragma unroll
        for (int ks = 0; ks < 2; ++ks) qf[c][ks] = *(const long*)(qp + c * 64 + ks * 32 + g4 * 8);
    f32x4 O[2][8], OL[2];
#pragma unroll
    for (int c = 0; c < 2; ++c) { OL[c] = (f32x4){0.f, 0.f, 0.f, 0.f};
#pragma unroll
        for (int db = 0; db < 8; ++db) O[c][db] = (f32x4){0.f, 0.f, 0.f, 0.f}; }
    float mrun0 = 0.f, mrun1 = 0.f;
    const unsigned char* vtb = Vt8 + ((long)(b * 8 + hd) * 128) * SK;
    const int sr0 = tid >> 3, sc0 = tid & 7;
    const int kp0 = 16 * ((sr0 >> 2) & 7) + 4 * (sr0 >> 5) + (sr0 & 3);
    const int vsw0 = sc0 ^ (2 * (((sr0 >> 2) ^ (sr0 >> 3)) & 1));
    u32x4 kreg0, kreg1, vreg0, vreg1;
#define ATT_LOAD(kt) do { const long krow = ((kt) < 32) ? ((long)b * SEQ + (kt) * 128) : ((long)RL + b * CTXL + ((kt) - 32) * 128); \
        kreg0 = *(const u32x4*)(K8 + (krow + sr0) * 1024 + hd * 128 + sc0 * 16); kreg1 = *(const u32x4*)(K8 + (krow + sr0 + 64) * 1024 + hd * 128 + sc0 * 16); \
        vreg0 = *(const u32x4*)(vtb + (long)sr0 * SK + (kt) * 128 + sc0 * 16); vreg1 = *(const u32x4*)(vtb + (long)(sr0 + 64) * SK + (kt) * 128 + sc0 * 16); } while (0)
#define ATT_STORE(bufi) do { *(u32x4*)(kbuf + (bufi) * AKBUF + kp0 * AROW + sc0 * 16) = kreg0; *(u32x4*)(kbuf + (bufi) * AKBUF + (kp0 + 8) * AROW + sc0 * 16) = kreg1; \
        *(u32x4*)(vbuf + (bufi) * AVBUF + sr0 * AROW + vsw0 * 16) = vreg0; *(u32x4*)(vbuf + (bufi) * AVBUF + (sr0 + 64) * AROW + vsw0 * 16) = vreg1; } while (0)
    ATT_LOAD(kt_lo); ATT_STORE(0);
    __syncthreads();
    int cur = 0;
    for (int kt = kt_lo; kt < kt_hi; ++kt) {
        const bool more = (kt + 1 < kt_hi), first = (kt == kt_lo);
        if (more) ATT_LOAD(kt + 1);
        __builtin_amdgcn_sched_barrier(0);
        const char* Kc = kbuf + cur * AKBUF; const char* Vc = vbuf + cur * AVBUF;
        v8i pf[2];
#pragma unroll
        for (int c = 0; c < 2; ++c) {
            float mr = c ? mrun1 : mrun0;
            f32x4 st[8];
#pragma unroll
            for (int mb = 0; mb < 8; ++mb) st[mb] = (f32x4){-mr, -mr, -mr, -mr};
            __builtin_amdgcn_s_setprio(1);
#pragma unroll
            for (int ks = 0; ks < 2; ++ks)
#pragma unroll
                for (int mb = 0; mb < 8; ++mb) {
                    const long kf = *(const long*)(Kc + (16 * mb + q) * AROW + c * 64 + ks * 32 + g4 * 8);
                    st[mb] = __builtin_amdgcn_mfma_f32_16x16x32_fp8_fp8(kf, qf[c][ks], st[mb], 0, 0, 0);
                }
            __builtin_amdgcn_s_setprio(0);
            float tmax, tm2;
            asm volatile("s_nop 7\n\ts_nop 7" : "+v"(st[0]), "+v"(st[1]), "+v"(st[2]), "+v"(st[3]), "+v"(st[4]), "+v"(st[5]), "+v"(st[6]), "+v"(st[7]));
            asm("v_max3_f32 %0, %1, %2, %3" : "=v"(tmax) : "v"(st[0][0]), "v"(st[0][1]), "v"(st[0][2]));
            asm("v_max3_f32 %0, %1, %2, %3" : "=v"(tm2) : "v"(st[0][3]), "v"(st[1][0]), "v"(st[1][1]));
#pragma unroll
            for (int mb = 1; mb < 8; ++mb) {
                if (mb > 1) { asm("v_max3_f32 %0, %1, %2, %3" : "+v"(tmax) : "v"(st[mb][0]), "v"(st[mb][1]), "v"(tmax)); }
                asm("v_max3_f32 %0, %1, %2, %3" : "+v"(tm2) : "v"(st[mb][2]), "v"(st[mb][3]), "v"(tm2));
            }
            asm("v_max3_f32 %0, %1, %2, %3" : "+v"(tmax) : "v"(st[1][0]), "v"(st[1][1]), "v"(tmax));
            asm("v_max3_f32 %0, %1, %2, %3" : "+v"(tmax) : "v"(tm2), "v"(tm2), "v"(tmax));
            { const auto r16 = __builtin_amdgcn_permlane16_swap(__float_as_uint(tmax), __float_as_uint(tmax), false, false); tmax = fmaxf(__uint_as_float(r16[0]), __uint_as_float(r16[1])); }
            { const auto r32 = __builtin_amdgcn_permlane32_swap(__float_as_uint(tmax), __float_as_uint(tmax), false, false); tmax = fmaxf(__uint_as_float(r32[0]), __uint_as_float(r32[1])); }
            if (first || __any(tmax > 8.f)) {
                asm volatile("" ::: "memory");
                const float delta = (first || tmax > 8.f) ? tmax - 6.f : 0.f;
                const float alpha = __builtin_amdgcn_exp2f(-delta);
                mr += delta;
#pragma unroll
                for (int mb = 0; mb < 8; ++mb) st[mb] -= delta;
#pragma unroll
                for (int db = 0; db < 8; ++db) O[c][db] *= alpha;
                OL[c] *= alpha;
            }
            if (c) mrun1 = mr; else mrun0 = mr;
            v8i pk;
#pragma unroll
            for (int mb = 0; mb < 8; ++mb)
                pk[mb] = (int)pack4f8(__builtin_amdgcn_exp2f(st[mb][0]), __builtin_amdgcn_exp2f(st[mb][1]), __builtin_amdgcn_exp2f(st[mb][2]), __builtin_amdgcn_exp2f(st[mb][3]));
            pf[c] = pk;
        }
        asm volatile("s_nop 1" : "+v"(pf[0]), "+v"(pf[1]));
        __builtin_amdgcn_s_setprio(1);
        {
            const int vsx = (g4 ^ (((q >> 2) ^ (q >> 3)) & 1)) * 32;
            const char* vr0 = Vc + q * AROW + vsx;
            v8i vfa = __builtin_shufflevector(*(const v4i*)(vr0), *(const v4i*)(vr0 + 16), 0, 1, 2, 3, 4, 5, 6, 7), vfb;
#pragma unroll
            for (int db = 0; db < 9; ++db) {
                if (db < 8) { const char* vr = Vc + ((db + 1) * 16 + q) * AROW + vsx;
                    vfb = __builtin_shufflevector(*(const v4i*)(vr), *(const v4i*)(vr + 16), 0, 1, 2, 3, 4, 5, 6, 7); }
                if (db < 8) {
                    asm("v_mfma_f32_16x16x128_f8f6f4 %0, %1, %2, %0" : "+v"(O[0][db]) : "v"(vfa), "v"(pf[0]));
                    asm("v_mfma_f32_16x16x128_f8f6f4 %0, %1, %2, %0" : "+v"(O[1][db]) : "v"(vfa), "v"(pf[1]));
                } else {
                    asm("v_mfma_f32_16x16x128_f8f6f4 %0, %1, %2, %0" : "+v"(OL[0]) : "v"(vfa), "v"(pf[0]));
                    asm("v_mfma_f32_16x16x128_f8f6f4 %0, %1, %2, %0" : "+v"(OL[1]) : "v"(vfa), "v"(pf[1]));
                }
                vfa = vfb;
            }
        }
        __builtin_amdgcn_s_setprio(0);
        if (more) ATT_STORE(cur ^ 1);
        __syncthreads();
        cur ^= 1;
    }
#undef ATT_LOAD
#undef ATT_STORE
    asm volatile("s_nop 7\n\ts_nop 7\n\ts_nop 7" : "+v"(O[0][0]), "+v"(O[0][1]), "+v"(O[0][2]), "+v"(O[0][3]), "+v"(O[0][4]), "+v"(O[0][5]), "+v"(O[0][6]), "+v"(O[0][7]),
                 "+v"(O[1][0]), "+v"(O[1][1]), "+v"(O[1][2]), "+v"(O[1][3]), "+v"(O[1][4]), "+v"(O[1][5]), "+v"(O[1][6]), "+v"(O[1][7]), "+v"(OL[0]), "+v"(OL[1]));
    const float l0 = __shfl(OL[0][0], q), l1 = __shfl(OL[1][0], q);
    const float i0 = 1.f / l0, i1 = lam / l1;
    float ss = 0.f;
#pragma unroll
    for (int db = 0; db < 8; ++db)
#pragma unroll
        for (int e = 0; e < 4; ++e) { const float o = O[0][db][e] * i0 - O[1][db][e] * i1; O[0][db][e] = o; ss += o * o; }
    ss += __shfl_xor(ss, 16); ss += __shfl_xor(ss, 32);
    const float rs = rsqrtf(ss * (1.f / 128.f) + 1e-6f) * post_scale * 4.f;
    unsigned char* yo = Yatt + (long)(qrow0 + wave * 16 + q) * 1024 + hd * 128;
#pragma unroll
    for (int db = 0; db < 8; ++db) {
        const int dv = db * 16 + g4 * 4; const f32x4 gg = *(const f32x4*)(subg + dv);
        const f32x4 ov = O[0][db] * gg * rs; *(unsigned*)(yo + dv) = pack4f8(ov[0], ov[1], ov[2], ov[3]);
    }
}

__device__ __forceinline__ unsigned fenc(float f) { const unsigned u = __float_as_uint(f); return u ^ ((unsigned)((int)u >> 31) | 0x80000000u); }
__device__ __forceinline__ float fdec(unsigned k) { return __uint_as_float(k ^ (~(unsigned)((int)k >> 31) | 0x80000000u)); }
#define INS32(L, x) do { unsigned _x = (x); _Pragma("unroll") for (int _i = 0; _i < 16; ++_i) { const unsigned _h = max(L[_i], _x); _x = min(L[_i], _x); L[_i] = _h; } } while (0)
#define INS64(L, x) do { unsigned long long _x = (x); _Pragma("unroll") for (int _i = 0; _i < 16; ++_i) { const unsigned long long _a = L[_i]; const bool _g = _a > _x; L[_i] = _g ? _a : _x; _x = _g ? _x : _a; } } while (0)
#define CSWAP_D(a, b) do { const unsigned _h = max(a, b), _l = min(a, b); a = _h; b = _l; } while (0)
__device__ __forceinline__ void sort16_desc(unsigned (&v)[16]) {
#pragma unroll
    for (int k = 2; k <= 16; k <<= 1)
#pragma unroll
        for (int j = k >> 1; j > 0; j >>= 1)
#pragma unroll
            for (int i = 0; i < 16; ++i) { const int l = i ^ j; if (l > i) { if ((i & k) == 0) CSWAP_D(v[i], v[l]); else CSWAP_D(v[l], v[i]); } }
}
__device__ __forceinline__ void merge16_desc(unsigned (&L)[16], const unsigned (&B)[16]) {
#pragma unroll
    for (int i = 0; i < 16; ++i) L[i] = max(L[i], B[15 - i]);
#pragma unroll
    for (int j = 8; j > 0; j >>= 1)
#pragma unroll
        for (int i = 0; i < 16; ++i) if ((i & j) == 0) CSWAP_D(L[i], L[i + j]);
}

__global__ void __launch_bounds__(512, 2) fwd_kernel(Params p) {
    extern __shared__ __attribute__((aligned(16))) unsigned char lds[];
    const int G = gridDim.x, bx = blockIdx.x;
    const int vb = (G % 8 == 0) ? (bx % 8) * (G / 8) + bx / 8 : bx;
    const int lo = p.ph_lo, hi = p.ph_hi;
    unsigned char* ws = p.ws;
    XcdBarrier bar; bar.bar = (unsigned*)(ws + WS_CTL); bar.x = 0; bar.st = nullptr;
    if (hi - lo > 1) {
        if (threadIdx.x == 0) *(uint4*)(lds + BAR_LDS_OFF) = make_uint4(0u, 0u, 0u, 0u);
        __syncthreads();
        bar = xcd_barrier_post((unsigned*)(ws + WS_CTL), (volatile LAS unsigned*)(lds + BAR_LDS_OFF));
    }
#define PH_IN(k) (lo <= (k) && (k) < hi)
#define PH_SEAM(k) do { if ((k) + 1 < hi) xcd_barrier(bar); } while (0)
    u16* shm16 = (u16*)lds;
    float* MODS = (float*)(ws + WS_MODS);
    float2* ROPE = (float2*)(ws + WS_ROPE);
    float* XC = (float*)(ws + WS_XC);
    u16* XB = (u16*)(ws + WS_XB);
    u16* Hb = (u16*)(ws + WS_H);
    u16* PD = (u16*)(ws + WS_PD); u16* UT = (u16*)(ws + WS_UT); u16* YG = (u16*)(ws + WS_YG);
    u16* POOLP = (u16*)(ws + WS_POOLP); u16* S5U = (u16*)(ws + WS_S5U); unsigned char* Q8 = ws + WS_Q; unsigned char* K8 = ws + WS_K;
    unsigned char* VT8 = ws + WS_VT; u16* GATE = (u16*)(ws + WS_GATE);
    unsigned char* YPOOL = ws + WS_YPOOL; unsigned char* YS5 = YPOOL + (size_t)R * 512; unsigned char* YATT = YPOOL + (size_t)R * 1024;
    unsigned char* MERGED8 = YPOOL + (size_t)R * 2048;
    u16* AC = (u16*)(ws + WS_AC); u16* AE = (u16*)(ws + WS_AE);
    float* EB = (float*)(ws + WS_E); _Float16* SCORES = (_Float16*)(ws + WS_SCORES);
    int* EL = (int*)(ws + WS_EL); float* GL = (float*)(ws + WS_GL);
    unsigned char* U8 = ws + WS_U16; unsigned char* V8 = ws + WS_V16;

    if (PH_IN(0)) {
        PH_TID
        u16* scr = (u16*)(lds + wave * 9216);
        const int gw = vb * 8 + wave, NGW = G * 8;
        constexpr int I_WIN = 32 * 160, I_BP = 8 * 32, I_BS = 8 * 32, I_BA = 16 * 32, I_WO = 32 * 32, I_GLU = 8 * 8, I_L = I_WIN + I_BP + I_BS + I_BA + I_WO + I_GLU;
        for (int it = gw; it < 2 * I_L; it += NGW) {
            const int l = it / I_L; int r = it % I_L;
            if (r < I_WIN) {
                if (!GATES_FP4 || r % 160 < 64) transpose_item8(pin(8) + (size_t)l * D * NIN, NIN, ws + WS_WIN + (size_t)l * NIN * D, D, (r / 160) * 64, (r % 160) * 64, (unsigned char*)scr, lane, 32.f);
                else transpose_item4(pin(8) + (size_t)l * D * NIN + 4096, NIN, ws + WS_W4 + (size_t)l * 6144 * 1024, 1024, (r / 160) * 64, (r % 160 - 64) * 64, (unsigned char*)scr, lane, G4_WS);
                continue; } r -= I_WIN;
            if (r < I_BP) { transpose_item8(pin(25) + (size_t)l * 512 * D, D, ws + WS_WBR + (size_t)l * D * D, D, (r / 32) * 64, (r % 32) * 64, (unsigned char*)scr, lane, 16.f); continue; } r -= I_BP;
            if (r < I_BS) { transpose_item8(pin(26) + (size_t)l * 512 * D, D, ws + WS_WBR + (size_t)l * D * D + 512, D, (r / 32) * 64, (r % 32) * 64, (unsigned char*)scr, lane, 16.f); continue; } r -= I_BS;
            if (r < I_BA) { transpose_item8(pin(27) + (size_t)l * 1024 * D, D, ws + WS_WBR + (size_t)l * D * D + 1024, D, (r / 32) * 64, (r % 32) * 64, (unsigned char*)scr, lane, 16.f); continue; } r -= I_BA;
            if (r < I_WO) { transpose_item8(pin(28) + (size_t)l * D * D, D, ws + WS_WOUT + (size_t)l * D * D, D, (r / 32) * 64, (r % 32) * 64, (unsigned char*)scr, lane, 32.f); continue; } r -= I_WO;
            transpose_item(pin(19) + (size_t)l * 512 * 512, 512, (u16*)(ws + WS_WGLU) + (size_t)l * 512 * 512, 512, (r / 8) * 64, (r % 8) * 64, scr, lane);
        }
        const long gt = (long)vb * 512 + tid, NGT = (long)G * 512;
        for (long i = gt; i < 2l * D * D / 4; i += NGT) {
            const float4 v = ((const float4*)pin(29))[i]; uint2 pk; pk.x = cvtpk(v.x, v.y); pk.y = cvtpk(v.z, v.w); ((uint2*)(ws + WS_WQ16))[i] = pk;
        }
        for (long i = gt; i < 2l * 8 * 256 * 256 / 4; i += NGT) {
            const long e = i * 4; const int cd = e & 255, ck = (e >> 8) & 255, hh = (e >> 16) & 7, l = e >> 19;
            const int c = ck >> 7, key = ck & 127, c2 = cd >> 7, d = cd & 127;
            uint2 pk = make_uint2(0u, 0u);
            if (c == c2) { const float4 v = *(const float4*)(pin(30) + ((((size_t)l * 8 + hh) * 2 + c) * 128 + key) * 128 + d); pk.x = cvtpk(v.x, v.y); pk.y = cvtpk(v.z, v.w); }
            ((uint2*)(ws + WS_KPAD))[i] = pk;
        }
        for (long i = gt; i < 2l * 512 * 512; i += NGT) {
            const int k = i & 511, n = (i >> 9) & 511, l = i >> 18;
            float v = 0.f;
            if ((k >> 7) == (n >> 7)) v = pin(9)[(((size_t)l * 4 + (n >> 7)) * 128 + (k & 127)) * 128 + (n & 127)];
            ((u16*)(ws + WS_WPOOL))[i] = (u16)(cvtpk(v, 0.f) & 0xffff);
        }
        for (long i = gt; i < 64 * 16; i += NGT) {
            const int pos = i >> 4, f = i & 15; const float fr = powf(10000.f, -(float)f / 16.f); const float a = (float)pos * fr; float s, c; sincosf(a, &s, &c);
            ROPE[i] = make_float2(c, s);
        }
        {
            float* sil = (float*)(lds + 18432);
            float* red = (float*)lds;
            __syncthreads();
            for (int i = tid; i < 9 * 2048; i += 512) { const int bb = i >> 11, k = i & 2047; const float cv = (bb < 8) ? pin(1)[bb * 2048 + k] : pin(3)[k]; sil[i] = cv * __builtin_amdgcn_rcpf(1.f + __builtin_amdgcn_exp2f(-1.4426950408889634f * cv)); }
            __syncthreads();
            for (int it = vb; it < 2 * 192; it += G) {
                const int l = it / 192, n0 = (it % 192) * 64;
                const float* w = pin(4) + (size_t)l * D * 12288 + n0 + lane;
                float a[9];
#pragma unroll
                for (int bb = 0; bb < 9; ++bb) a[bb] = 0.f;
                const int k0 = wave * 256;
#pragma unroll 32
                for (int k = 0; k < 256; ++k) {
                    const float wv = w[(size_t)(k0 + k) * 12288];
#pragma unroll
                    for (int bb = 0; bb < 9; ++bb) a[bb] += sil[bb * 2048 + k0 + k] * wv;
                }
#pragma unroll
                for (int bb = 0; bb < 9; ++bb) red[(wave * 9 + bb) * 64 + lane] = a[bb];
                __syncthreads();
                for (int i = tid; i < 9 * 64; i += 512) {
                    float s = 0.f;
#pragma unroll
                    for (int wv = 0; wv < 8; ++wv) s += red[wv * 576 + i];
                    const int bb = i >> 6, nn = i & 63;
                    MODS[((size_t)l * 9 + bb) * 12288 + n0 + nn] = s + pin(5)[(size_t)l * 12288 + n0 + nn];
                }
                __syncthreads();
            }
        }
        PH_SEAM(0);
    }

    for (int l = 0; l < 2; ++l) {
        const int P0 = 1 + l * NPL;
        const float* xl_in = pin(0);
        const float* xc_in = (l == 0) ? pin(2) : XC;
        const float* mods = MODS + (size_t)l * 9 * 12288;
        const int Ract = (l == 0) ? R : RL;
        const float lam_init = (l == 0) ? 0.2f : (0.8f - 0.6f * 0.7408182206817179f);
        const unsigned char* WIN8 = ws + WS_WIN + (size_t)l * NIN * D;
        const unsigned char* WBR8 = ws + WS_WBR + (size_t)l * D * D;
        const unsigned char* WOUT8 = ws + WS_WOUT + (size_t)l * D * D;
        const unsigned char* WPK8 = ws + WS_WPK + (size_t)l * D * D;

        if (l == 0 && PH_IN(P0 + 0)) {
            PH_TID
            for (int t = vb; t < 128; t += G) {
                const int l2 = t >> 6, kt = t & 7, hh = (t >> 3) & 7;
                EpiStoreF8 e{ws + WS_WPK + (size_t)l2 * D * D + (size_t)(hh * 256) * D + kt * 256, 32.f};
                gemm_tile<false>((const u16*)(ws + WS_WQ16) + (size_t)l2 * D * D + (size_t)(kt * 256) * D + hh * 256, D,
                          (const u16*)(ws + WS_KPAD) + ((size_t)l2 * 8 + hh) * 65536, 256, 256, shm16, e);
            }
            for (int r = vb * 8 + wave; r < R; r += G * 8) {
                const int bb = (r < RL) ? (r >> 12) : 8;
                const float* xr = (r < RL) ? xl_in + (size_t)r * D : xc_in + (size_t)(r - RL) * D;
                rms_mod_row<true>(xr, pin(6) + l * D, mods + bb * 12288, mods + bb * 12288 + D, (unsigned char*)Hb + (size_t)r * D, lane, GATES_FP4 ? (unsigned*)(ws + WS_H4 + (size_t)r * 1024) : nullptr);
            }
            PH_SEAM(P0 + 0);
        }

        if (PH_IN(P0 + 1)) {
            PH_TID
            constexpr int NTI = NIN / 256, NTJ = R / 256, GM = 8;
            for (int t = vb; t < NTI * NTJ; t += G) {
                const int grp = t / (GM * NTI), rem = t % (GM * NTI), rt = grp * GM + rem % GM, ct = rem / GM;
                const int f0 = ct * 256;
                if (l == 1 && rt >= 128 && !(f0 >= 512 && f0 < 1024) && !(f0 >= 2048 && f0 < 4096)) continue;
                const u16* Wt = (const u16*)(WIN8 + (size_t)f0 * D); const u16* At_ = (const u16*)((const unsigned char*)Hb + (size_t)rt * 256 * D);
                if (f0 >= 3072 && f0 < 4096) {
                    const int b = (rt < 128) ? (rt >> 4) : (rt - 128), key0 = (rt < 128) ? (rt & 15) * 256 : SEQ;
                    EpiV e{VT8 + ((size_t)b * 1024 + (f0 - 3072)) * SK + key0};
                    gemm_tile<true>(At_, D / 2, Wt, D / 2, D / 2, shm16, e);
                } else {
                    EpiG1 e; e.rope = ROPE; e.qscale = 1.f; e.wsc = 1.f / 32.f; e.lat = (rt < 128); e.t0 = (rt & 15) * 256; e.kind = 0;
                    const size_t r0 = (size_t)rt * 256;
                    if (f0 < 512) { e.out = POOLP + r0 * 512 + f0; e.ldo = 512; }
                    else if (f0 < 1024) { e.out = S5U + r0 * 512 + (f0 - 512); e.ldo = 512; }
                    else if (f0 < 2048) { e.out = Q8 + r0 * 1024 + (f0 - 1024); e.ldo = 1024; e.kind = 1; e.qscale = 4.f * 0.125f * 1.4426950408889634f; }
                    else if (f0 < 3072) { e.out = K8 + r0 * 1024 + (f0 - 2048); e.ldo = 1024; e.kind = 2; e.qscale = 0.25f; }
                    else { e.out = (unsigned char*)GATE + r0 * 6144 + (f0 - 4096); e.ldo = 6144; e.kind = 3; e.qscale = 128.f; }
                    if (GATES_FP4 && f0 >= 4096) {
                        e.wsc = 1.f / (G4_HS * G4_WS);
                        gemm_tile<2>((const u16*)(ws + WS_W4 + ((size_t)l * 6144 + (f0 - 4096)) * 1024), D / 4, (const u16*)(ws + WS_H4 + (size_t)rt * 256 * 1024), D / 4, D / 4, shm16, e);
                    } else
                    gemm_tile<true>(Wt, D / 2, At_, D / 2, D / 2, shm16, e);
                }
            }
            PH_SEAM(P0 + 1);
        }

        if (PH_IN(P0 + 2)) {
            PH_TID
            const long gt = (long)vb * 512 + tid, NGT = (long)G * 512;
            for (long i = gt; i < (long)Ract * 64; i += NGT) {
                const int ch = i & 63; const long r = i >> 6;
                const int gi = ch >> 4, win = 2 << gi;
                long base; int t, S;
                if (r < RL) { base = r & ~(long)(SEQ - 1); t = r & (SEQ - 1); S = SEQ; } else { base = RL + ((r - RL) & ~(long)(CTXL - 1)); t = (r - RL) & (CTXL - 1); S = CTXL; }
                const int lo_ = max(t - win / 2, 0), hi_ = min(t + win - 1 - win / 2, S - 1);
                float s[8];
#pragma unroll
                for (int e = 0; e < 8; ++e) s[e] = 0.f;
                uint4 wv[16];
#pragma unroll
                for (int j = 0; j < 16; ++j) { const int tt = min(lo_ + j, hi_); wv[j] = *(const uint4*)(POOLP + (base + tt) * 512 + ch * 8); }
#pragma unroll
                for (int j = 0; j < 16; ++j) if (lo_ + j <= hi_) { const uint4 v = wv[j];
                    s[0] += bflo(v.x); s[1] += bfhi(v.x); s[2] += bflo(v.y); s[3] += bfhi(v.y); s[4] += bflo(v.z); s[5] += bfhi(v.z); s[6] += bflo(v.w); s[7] += bfhi(v.w); }
                const float inv = 1.f / (float)(hi_ - lo_ + 1);
                const uint4 c = *(const uint4*)(POOLP + r * 512 + ch * 8);
                uint4 o;
                o.x = cvtpk(s[0] * inv - bflo(c.x), s[1] * inv - bfhi(c.x)); o.y = cvtpk(s[2] * inv - bflo(c.y), s[3] * inv - bfhi(c.y));
                o.z = cvtpk(s[4] * inv - bflo(c.z), s[5] * inv - bfhi(c.z)); o.w = cvtpk(s[6] * inv - bflo(c.w), s[7] * inv - bfhi(c.w));
                *(uint4*)(PD + r * 512 + ch * 8) = o;
            }
            for (long i = gt; i < 32l * 1088 * 64; i += NGT) {
                const int hf = i & 1, s = (i >> 1) & 31; const long gn = i >> 6; const int n = gn % 1088, g = gn / 1088;
                const long row = (n < 1024) ? ((long)(n >> 7) * SEQ + (n & 127) * S5L + s) : ((long)RL + ((n - 1024) >> 3) * CTXL + ((n - 1024) & 7) * S5L + s);
                *(uint4*)(UT + ((size_t)g * S5N + n) * S5K + s * 16 + hf * 8) = *(const uint4*)(S5U + row * 512 + g * 16 + hf * 8);
            }
            {
            const float* a_re = pin(11) + l * 4096; const float* a_im = pin(12) + l * 4096; const float* ldt = pin(13) + l * 64;
            const float* b_re = pin(14) + (size_t)l * 65536; const float* b_im = pin(15) + (size_t)l * 65536;
            const float* c_re = pin(16) + (size_t)l * 65536; const float* c_im = pin(17) + (size_t)l * 65536;
            const float* dsk = pin(18) + l * 512;
            {
                float* wre = (float*)lds;
                float* wim = wre + 2048;
                float* kdv = wim + 2048;
                for (int it = vb; it < 32 * 32; it += G) {
                    const int g = it >> 5, d = it & 31;
                    __syncthreads();
                    for (int i = tid; i < 2048; i += 512) {
                        const int dir = i >> 10, pp = (i >> 4) & 63, j = i & 15;
                        const int gi = (dir * 32 + g) * 64 + pp;
                        const float ar = a_re[gi], ai = a_im[gi], dt = expf(ldt[dir * 32 + g]);
                        float cr, ci, lr, li; s5_coef(ar, ai, dt, cr, ci); s5_lampow(ar, ai, dt, (float)d, lr, li);
                        const float br = b_re[(size_t)gi * 16 + j], bi = b_im[(size_t)gi * 16 + j];
                        const float bbr = cr * br - ci * bi, bbi = cr * bi + ci * br;
                        wre[i] = lr * bbr - li * bbi; wim[i] = lr * bbi + li * bbr;
                    }
                    __syncthreads();
                    const int dir = tid >> 8, ii = (tid >> 4) & 15, j = tid & 15;
                    const float* cr_ = c_re + ((size_t)(dir * 32 + g) * 16 + ii) * 64; const float* ci_ = c_im + ((size_t)(dir * 32 + g) * 16 + ii) * 64;
                    float kv = 0.f;
#pragma unroll 8
                    for (int pp = 0; pp < 64; ++pp) kv += cr_[pp] * wre[(dir * 64 + pp) * 16 + j] - ci_[pp] * wim[(dir * 64 + pp) * 16 + j];
                    kdv[tid] = kv;
                    __syncthreads();
                    u16* acg = AC + (size_t)g * 512 * S5K;
                    if (d == 0) {
                        if (dir == 0) { const float v = kdv[tid] + kdv[256 + tid] + ((ii == j) ? dsk[g * 16 + ii] : 0.f); const u16 hv = (u16)(cvtpk(v, 0.f) & 0xffff);
                            for (int t = 0; t < 32; ++t) acg[(size_t)(t * 16 + ii) * S5K + t * 16 + j] = hv; }
                    } else {
                        const u16 hv = (u16)(cvtpk(kv, 0.f) & 0xffff);
                        if (dir == 0) { for (int t = d; t < 32; ++t) acg[(size_t)(t * 16 + ii) * S5K + (t - d) * 16 + j] = hv; }
                        else { for (int t = 0; t < 32 - d; ++t) acg[(size_t)(t * 16 + ii) * S5K + (t + d) * 16 + j] = hv; }
                    }
                }
                __syncthreads();
            }
            {
                const long gt = (long)vb * 512 + tid, NGT = (long)G * 512;
                for (long i = gt; i < 32l * 512 * 256; i += NGT) {
                    const int col = i & 255, row = (i >> 8) & 511, g = i >> 17;
                    const int dir = col >> 7, im = (col >> 6) & 1, pp = col & 63, t = row >> 4, ii = row & 15;
                    const int gi = (dir * 32 + g) * 64 + pp;
                    const float dt = expf(ldt[dir * 32 + g]);
                    float lr, li; s5_lampow(a_re[gi], a_im[gi], dt, (dir == 0) ? (float)(t + 1) : (float)(32 - t), lr, li);
                    const float cr = c_re[((size_t)(dir * 32 + g) * 16 + ii) * 64 + pp], ci = c_im[((size_t)(dir * 32 + g) * 16 + ii) * 64 + pp];
                    const float v = im ? -(cr * li + ci * lr) : (cr * lr - ci * li);
                    AC[((size_t)g * 512 + row) * S5K + 512 + col] = (u16)(cvtpk(v, 0.f) & 0xffff);
                }
                for (long i = gt; i < 32l * 256 * 512; i += NGT) {
                    const int col = i & 511, row = (i >> 9) & 255, g = i >> 17;
                    const int dir = row >> 7, im = (row >> 6) & 1, pp = row & 63, s = col >> 4, j = col & 15;
                    const int gi = (dir * 32 + g) * 64 + pp;
                    const float ar = a_re[gi], ai = a_im[gi], dt = expf(ldt[dir * 32 + g]);
                    float cr, ci, lr, li; s5_coef(ar, ai, dt, cr, ci); s5_lampow(ar, ai, dt, (dir == 0) ? (float)(31 - s) : (float)s, lr, li);
                    const float br = b_re[(size_t)gi * 16 + j], bi = b_im[(size_t)gi * 16 + j];
                    const float bbr = cr * br - ci * bi, bbi = cr * bi + ci * br;
                    const float v = im ? (lr * bbi + li * bbr) : (lr * bbr - li * bbi);
                    AE[((size_t)g * 256 + row) * 512 + col] = (u16)(cvtpk(v, 0.f) & 0xffff);
                }
            }
            }
            PH_SEAM(P0 + 2);
        }

        if (PH_IN(P0 + 3)) {
            PH_TID
            const u16* WPOOL = (const u16*)(ws + WS_WPOOL) + (size_t)l * 512 * 512;
            const int NT_POOL = 2 * (Ract / 256); constexpr int NT_E = 32 * 5;
            for (int t = vb; t < NT_POOL; t += G) {
                const int ct = t & 1, rt = t >> 1;
                EpiPool e{YPOOL + (size_t)rt * 256 * 512 + ct * 256, pin(10) + l * 512 + ct * 256};
                gemm_tile<false>(WPOOL + (size_t)ct * 256 * 512, 512, PD + (size_t)rt * 256 * 512, 512, 512, shm16, e);
            }
            for (int u = (vb + G - (NT_POOL % G)) % G; u < NT_E; u += G) {
                const int g = u / 5, nt = u % 5;
                EpiS5E e{EB + ((size_t)g * S5N + nt * 256) * 256};
                gemm_tile<false>(AE + (size_t)g * 256 * 512, 512, UT + ((size_t)g * S5N + nt * 256) * S5K, S5K, 512, shm16, e);
            }
            PH_SEAM(P0 + 3);
        }

        if (PH_IN(P0 + 4)) {
            PH_TID
            int vbs = vb; asm volatile("" : "+s"(vbs));
            if (vbs < 64) {
                const int gi = vbs * 512 + tid; const int pp = gi & 63, dir = (gi >> 6) & 1, g = (gi >> 7) & 31, b = gi >> 12;
                const int pi = (dir * 32 + g) * 64 + pp;
                const float dt = expf(pin(13)[l * 64 + dir * 32 + g]);
                float Lr, Li; s5_lampow(pin(11)[l * 4096 + pi], pin(12)[l * 4096 + pi], dt, 32.f, Lr, Li);
                float hr = 0.f, hi_ = 0.f;
                for (int st0 = 0; st0 < 136; st0 += 17) {
                    float er[17], ei[17]; size_t gnv[17];
#pragma unroll
                    for (int j = 0; j < 17; ++j) {
                        const int st = st0 + j; int n;
                        if (dir == 0) n = (st < 8) ? (1024 + b * 8 + st) : (b * 128 + (st - 8));
                        else n = (st < 8) ? (1024 + b * 8 + (7 - st)) : (b * 128 + (135 - st));
                        gnv[j] = (size_t)g * S5N + n;
                        er[j] = EB[gnv[j] * 256 + dir * 128 + pp]; ei[j] = EB[gnv[j] * 256 + dir * 128 + 64 + pp];
                    }
#pragma unroll
                    for (int j = 0; j < 17; ++j) {
                        u16* ho = UT + gnv[j] * S5K + 512 + dir * 128 + pp;
                        ho[0] = (u16)(cvtpk(hr, 0.f) & 0xffff); ho[64] = (u16)(cvtpk(hi_, 0.f) & 0xffff);
                        const float nr = Lr * hr - Li * hi_ + er[j], ni = Lr * hi_ + Li * hr + ei[j];
                        hr = nr; hi_ = ni;
                    }
                }
            }
            float s1 = 0.f, s2 = 0.f;
            { s1 = pin(20)[l * 64 + lane] * pin(21)[l * 64 + lane]; s2 = pin(22)[l * 64 + lane] * pin(23)[l * 64 + lane];
#pragma unroll
              for (int of = 32; of > 0; of >>= 1) { s1 += __shfl_xor(s1, of); s2 += __shfl_xor(s2, of); } }
            const float lam = expf(s1) - expf(s2) + lam_init;
            const int nunits = 2048 + ((l == 0) ? 128 : 0);
            attn_prep((char*)lds);
            const bool shiftc = (l == 0) && (G == 256);
            for (int u0 = vb; u0 < nunits + (shiftc ? 128 : 0); u0 += G) {
                int u = u0;
                if (shiftc && u0 >= 2048) { if (u0 < 2048 + 128) continue; u = u0 - 128; }
                int b, hd, qrow0, k_lo;
                if (u < 2048) { b = u >> 8; hd = (u >> 5) & 7; qrow0 = b * SEQ + (u & 31) * 128; k_lo = 0; }
                else { const int v = u - 2048; b = v >> 4; hd = (v >> 1) & 7; qrow0 = RL + b * CTXL + (v & 1) * 128; k_lo = 32; }
                attn_unit(Q8, K8, VT8, YATT, b, hd, qrow0, k_lo, 34, lam, 1.f - lam_init, pin(24) + l * 128, (char*)lds);
            }
            PH_SEAM(P0 + 4);
        }

        if (PH_IN(P0 + 5)) {
            PH_TID
            const int ntn = (l == 0) ? 10 : 8;
            for (int t = vb; t < 32 * ntn; t += G) {
                const int g = t / ntn, r = t % ntn, it = r & 1, nt = r >> 1;
                EpiS5Y e{YG, g, it, nt};
                gemm_tile<false>(AC + ((size_t)g * 512 + it * 256) * S5K, S5K, UT + ((size_t)g * S5N + nt * 256) * S5K, S5K, S5K, shm16, e);
            }
            PH_SEAM(P0 + 5);
        }

        if (PH_IN(P0 + 6)) {
            PH_TID
            const u16* WGLU = (const u16*)(ws + WS_WGLU) + (size_t)l * 512 * 512;
            for (int t = vb; t < 2 * (Ract / 256); t += G) {
                const int ct = t & 1, rt = t >> 1;
                const size_t o = (size_t)rt * 256 * 512 + ct * 256;
                EpiGlu e{YS5 + o, YG + o};
                gemm_tile<false>(WGLU + (size_t)ct * 256 * 512, 512, YG + (size_t)rt * 256 * 512, 512, 512, shm16, e);
            }
            PH_SEAM(P0 + 6);
        }

        if (PH_IN(P0 + 7)) {
            PH_TID
            constexpr int NTI = 8, GM = 8; const int NTJ = Ract / 256;
            for (int t = vb; t < NTI * NTJ; t += G) {
                const int grp = t / (GM * NTI), rem = t % (GM * NTI), rt = grp * GM + rem % GM, ct = rem / GM;
                const size_t r0 = (size_t)rt * 256; const int n0 = ct * 256;
                Acc macc = {};
#pragma unroll 1
                for (int br = 0; br < 3; ++br) {
                    EpiMerge e{MERGED8 + r0 * D + n0, (const unsigned char*)GATE + r0 * 6144 + br * 2048 + n0, br};
                    const u16* Wt = (const u16*)(WBR8 + (size_t)n0 * D + ((br == 0) ? 0 : (br == 1) ? 512 : 1024));
                    const u16* Ab = (const u16*)((br == 0) ? YPOOL + r0 * 512 : (br == 1) ? YS5 + r0 * 512 : YATT + r0 * 1024);
                    gemm_tile_acc<true>(Wt, D / 2, Ab, (br == 2) ? 512 : 256, (br == 2) ? 512 : 256, shm16, macc, e);
                }
            }
            PH_SEAM(P0 + 7);
        }

        if (PH_IN(P0 + 8)) {
            PH_TID
            constexpr int NTI = 8, GM = 8; const int NTJ = Ract / 256;
            for (int t = vb; t < NTI * NTJ; t += G) {
                const int grp = t / (GM * NTI), rem = t % (GM * NTI), rt = grp * GM + rem % GM, ct = rem / GM;
                const size_t r0 = (size_t)rt * 256; const int n0 = ct * 256;
                const int bb = (rt < 128) ? (rt >> 4) : 8;
                const void* xin = (rt < 128) ? ((l == 0) ? (const void*)(pin(0) + r0 * D + n0) : (const void*)(XB + r0 * D + n0)) : (const void*)(xc_in + (r0 - RL) * D + n0);
                void* xout = (rt < 128) ? (void*)(XB + r0 * D + n0) : (void*)(XC + (r0 - RL) * D + n0);
                EpiRes e{xin, xout, mods + bb * 12288 + 2 * D + n0, 1.f / 128.f, (rt < 128) && (l == 1), (rt < 128)};
                gemm_tile<true>((const u16*)(WOUT8 + (size_t)n0 * D), D / 2, (const u16*)(MERGED8 + r0 * D), D / 2, D / 2, shm16, e);
            }
            PH_SEAM(P0 + 8);
        }

        if (PH_IN(P0 + 9)) {
            PH_TID
            for (int r = vb * 8 + wave; r < Ract; r += G * 8) {
                const int bb = (r < RL) ? (r >> 12) : 8;
                if (r < RL) rms_mod_row<true, true>(XB + (size_t)r * D, pin(7) + l * D, mods + bb * 12288 + 3 * D, mods + bb * 12288 + 4 * D, MERGED8 + (size_t)r * D, lane);
                else rms_mod_row<true, false>(XC + (size_t)(r - RL) * D, pin(7) + l * D, mods + bb * 12288 + 3 * D, mods + bb * 12288 + 4 * D, MERGED8 + (size_t)r * D, lane);
            }
            const long gt = (long)vb * 512 + tid, NGT = (long)G * 512;
            for (long i = gt; i < 9l * 3 * 2048; i += NGT) {
                const int b9 = (int)(i / 6144), vs_ = (int)(i / 2048) % 3, pp = (int)(i & 2047);
                const int c = ((pp >> 3) & 63) * 32 + (pp >> 9) * 8 + (pp & 7);
                float val;
                if (vs_ == 0) val = mods[b9 * 12288 + 5 * D + c];
                else if (l == 0) { const float* m1 = MODS + (size_t)9 * 12288 + b9 * 12288; val = (vs_ == 1) ? pin(6)[D + c] * (1.f + m1[D + c]) : m1[c]; }
                else val = pin(33)[c];
                ((u16*)(ws + WS_PERM))[i] = (u16)(cvtpk(val, 0.f) & 0xffff);
            }
            const float4* us = (const float4*)(pin(31) + (size_t)l * 16384 * D); const float4* vs = (const float4*)(pin(32) + (size_t)l * 16384 * D);
            for (long i = gt; i < 16384l * D / 32; i += NGT) {
                u32x4 pu, pv;
#pragma unroll
                for (int dd = 0; dd < 4; ++dd) {
                    const float4 a0 = us[i * 8 + dd * 2], a1 = us[i * 8 + dd * 2 + 1], c0 = vs[i * 8 + dd * 2], c1 = vs[i * 8 + dd * 2 + 1];
                    unsigned x = 0u, y = 0u;
                    x = __builtin_amdgcn_cvt_scalef32_pk_fp4_f32(x, a0.x * PEER_USC, a0.y * PEER_USC, 1.0f, 0); x = __builtin_amdgcn_cvt_scalef32_pk_fp4_f32(x, a0.z * PEER_USC, a0.w * PEER_USC, 1.0f, 1);
                    x = __builtin_amdgcn_cvt_scalef32_pk_fp4_f32(x, a1.x * PEER_USC, a1.y * PEER_USC, 1.0f, 2); x = __builtin_amdgcn_cvt_scalef32_pk_fp4_f32(x, a1.z * PEER_USC, a1.w * PEER_USC, 1.0f, 3);
                    y = __builtin_amdgcn_cvt_scalef32_pk_fp4_f32(y, c0.x * PEER_VSC, c0.y * PEER_VSC, 1.0f, 0); y = __builtin_amdgcn_cvt_scalef32_pk_fp4_f32(y, c0.z * PEER_VSC, c0.w * PEER_VSC, 1.0f, 1);
                    y = __builtin_amdgcn_cvt_scalef32_pk_fp4_f32(y, c1.x * PEER_VSC, c1.y * PEER_VSC, 1.0f, 2); y = __builtin_amdgcn_cvt_scalef32_pk_fp4_f32(y, c1.z * PEER_VSC, c1.w * PEER_VSC, 1.0f, 3);
                    pu[dd] = x; pv[dd] = y;
                }
                ((u32x4*)U8)[i] = pu; ((u32x4*)V8)[i] = pv;
            }
            PH_SEAM(P0 + 9);
        }

        if (PH_IN(P0 + 10)) {
            PH_TID
            constexpr int NTI = 8, GM = 8; const int NTJ = Ract / 256;
            for (int t = vb; t < NTI * NTJ; t += G) {
                const int grp = t / (GM * NTI), rem = t % (GM * NTI), rt = grp * GM + rem % GM, ct = rem / GM;
                const size_t r0 = (size_t)rt * 256; const int n0 = ct * 256;
                EpiF16 e{SCORES + r0 * 2048 + n0, 1.f / 32.f};
                gemm_tile<1>((const u16*)(WPK8 + (size_t)n0 * D), D / 2, (const u16*)(MERGED8 + r0 * D), D / 2, D / 2, shm16, e);
            }
            PH_SEAM(P0 + 10);
        }

        if (PH_IN(P0 + 11)) {
            PH_TID
            const long gt = (long)vb * 512 + tid, NGT = (long)G * 512;
            for (long i = gt; i < (long)Ract * 8; i += NGT) {
                const u32x4* sc = (const u32x4*)(SCORES + i * 256);
                unsigned L1[16], L2[16];
#pragma unroll
                for (int k = 0; k < 16; ++k) { L1[k] = 0u; L2[k] = 0u; }
#pragma unroll 1
                for (int gq = 0; gq < 8; ++gq) {
                    const u32x4 a0 = sc[2 * gq], a1 = sc[2 * gq + 1], c0 = sc[16 + 2 * gq], c1 = sc[16 + 2 * gq + 1];
                    unsigned B1[16], B2[16];
#pragma unroll
                    for (int d = 0; d < 4; ++d) {
                        const unsigned x0 = a0[d], x1 = a1[d], y0 = c0[d], y1 = c1[d];
                        const h16x2 xa = __builtin_bit_cast(h16x2, x0), xb = __builtin_bit_cast(h16x2, x1), ya = __builtin_bit_cast(h16x2, y0), yb = __builtin_bit_cast(h16x2, y1);
                        const unsigned id = (unsigned)(16 * gq + 2 * d);
                        B1[2 * d] = (fenc((float)xa[0]) & ~127u) | id; B1[2 * d + 1] = (fenc((float)xa[1]) & ~127u) | (id + 1);
                        B1[8 + 2 * d] = (fenc((float)xb[0]) & ~127u) | (id + 8); B1[8 + 2 * d + 1] = (fenc((float)xb[1]) & ~127u) | (id + 9);
                        B2[2 * d] = (fenc((float)ya[0]) & ~127u) | id; B2[2 * d + 1] = (fenc((float)ya[1]) & ~127u) | (id + 1);
                        B2[8 + 2 * d] = (fenc((float)yb[0]) & ~127u) | (id + 8); B2[8 + 2 * d + 1] = (fenc((float)yb[1]) & ~127u) | (id + 9);
                    }
                    sort16_desc(B1); merge16_desc(L1, B1);
                    sort16_desc(B2); merge16_desc(L2, B2);
                }
                unsigned T[16];
#pragma unroll
                for (int k = 0; k < 16; ++k) T[k] = 0u;
#pragma unroll
                for (int a = 0; a < 16; ++a) {
                    const float va = fdec(L1[a] & ~127u); const unsigned ia = L1[a] & 127u;
#pragma unroll
                    for (int c = 0; c < 16; ++c) {
                        if ((a + 1) * (c + 1) <= 16) {
                            const float vs = va + fdec(L2[c] & ~127u);
                            INS32(T, (fenc(vs) & ~0x3FFFu) | (ia << 7) | (L2[c] & 127u));
                        }
                    }
                }
                float w[16]; float sum = 0.f; const float mx = fdec(T[0] & ~0x3FFFu);
#pragma unroll
                for (int k = 0; k < 16; ++k) { w[k] = __expf(fdec(T[k] & ~0x3FFFu) - mx); sum += w[k]; }
                const float inv = 1.f / sum;
                int4* eo = (int4*)(EL + i * 16); float4* go = (float4*)(GL + i * 16);
#pragma unroll
                for (int k = 0; k < 4; ++k) {
                    eo[k] = make_int4((int)(T[4 * k] & 0x3FFFu), (int)(T[4 * k + 1] & 0x3FFFu), (int)(T[4 * k + 2] & 0x3FFFu), (int)(T[4 * k + 3] & 0x3FFFu));
                    go[k] = make_float4(w[4 * k] * inv, w[4 * k + 1] * inv, w[4 * k + 2] * inv, w[4 * k + 3] * inv);
                }
            }
            PH_SEAM(P0 + 11);
        }

        if (PH_IN(P0 + 12)) {
            PH_TID
            for (int r = vb * 8 + wave; r < Ract; r += G * 8) {
                const int e0 = EL[(size_t)r * 128 + lane], e1 = EL[(size_t)r * 128 + 64 + lane];
                const float g0 = GL[(size_t)r * 128 + lane], g1 = GL[(size_t)r * 128 + 64 + lane];
                h16x2 hh[16];
                {
                    const unsigned char* hrow = MERGED8 + (size_t)r * D + lane * 32;
#pragma unroll
                    for (int c2 = 0; c2 < 2; ++c2) { const u32x4 t4 = *(const u32x4*)(hrow + c2 * 16);
#pragma unroll
                        for (int d = 0; d < 4; ++d) { const unsigned td = t4[d];
                            hh[c2 * 8 + 2 * d] = __builtin_amdgcn_cvt_scalef32_pk_f16_fp8(td, 1.0f, false); hh[c2 * 8 + 2 * d + 1] = __builtin_amdgcn_cvt_scalef32_pk_f16_fp8(td, 1.0f, true); } }
                }
                float w0 = 0.f, w1 = 0.f;
#pragma unroll 1
                for (int hd = 0; hd < 8; ++hd) {
                    const int esel = (hd < 4) ? e0 : e1; const int lb = (hd & 3) * 16;
                    u32x4 ua[16];
#pragma unroll
                    for (int k = 0; k < 16; ++k) { const int ek = __builtin_amdgcn_readlane(esel, lb + k); ua[k] = *(const u32x4*)(U8 + (size_t)ek * (D / 2) + lane * 16); }
                    float part[16];
#pragma unroll
                    for (int k = 0; k < 16; ++k) {
                        h16x2 acc = (h16x2){(_Float16)0.f, (_Float16)0.f};
#pragma unroll
                        for (int d = 0; d < 4; ++d) {
                            acc = __builtin_elementwise_fma(CVT4H(ua[k][d], 0), hh[4 * d + 0], acc);
                            acc = __builtin_elementwise_fma(CVT4H(ua[k][d], 1), hh[4 * d + 1], acc);
                            acc = __builtin_elementwise_fma(CVT4H(ua[k][d], 2), hh[4 * d + 2], acc);
                            acc = __builtin_elementwise_fma(CVT4H(ua[k][d], 3), hh[4 * d + 3], acc);
                        }
                        part[k] = (float)acc[0] + (float)acc[1];
                    }
                    float p8[8], p4[4], p2[2], p1;
#pragma unroll
                    for (int k = 0; k < 8; ++k) { const auto x_ = __builtin_amdgcn_permlane32_swap(__float_as_uint(part[k]), __float_as_uint(part[8 + k]), false, false);
                        p8[k] = __uint_as_float(x_[0]) + __uint_as_float(x_[1]); }
#pragma unroll
                    for (int k = 0; k < 4; ++k) { const auto x_ = __builtin_amdgcn_permlane16_swap(__float_as_uint(p8[k]), __float_as_uint(p8[4 + k]), false, false);
                        p4[k] = __uint_as_float(x_[0]) + __uint_as_float(x_[1]); }
                    { const bool up_ = lane & 8;
#pragma unroll
                      for (int k = 0; k < 2; ++k) { const float keep = up_ ? p4[2 + k] : p4[k], send = up_ ? p4[k] : p4[2 + k]; p2[k] = keep + __shfl_xor(send, 8); } }
                    { const bool up_ = lane & 4; const float keep = up_ ? p2[1] : p2[0], send = up_ ? p2[0] : p2[1]; p1 = keep + __shfl_xor(send, 4); }
                    p1 += __shfl_xor(p1, 2); p1 += __shfl_xor(p1, 1);
                    const float tv = __shfl(p1, 4 * (lane & 15));
                    if ((lane >> 4) == (hd & 3)) { if (hd < 4) w0 = tv; else w1 = tv; }
                }
                GL[(size_t)r * 128 + lane] = g0 * gelu_tanh(w0 * (1.f / PEER_USC)); GL[(size_t)r * 128 + 64 + lane] = g1 * gelu_tanh(w1 * (1.f / PEER_USC));
            }
            PH_SEAM(P0 + 12);
        }

        if (PH_IN(P0 + 13)) {
            PH_TID
            for (int r = vb * 8 + wave; r < Ract; r += G * 8) {
                const int bb = (r < RL) ? (r >> 12) : 8;
                const int e0 = EL[(size_t)r * 128 + lane], e1 = EL[(size_t)r * 128 + 64 + lane];
                const float w0 = GL[(size_t)r * 128 + lane], w1 = GL[(size_t)r * 128 + 64 + lane];
                h16x2 oo[16];
#pragma unroll
                for (int i = 0; i < 16; ++i) oo[i] = (h16x2){(_Float16)0.f, (_Float16)0.f};
#pragma unroll 1
                for (int hd = 0; hd < 8; ++hd) {
                    const int esel = (hd < 4) ? e0 : e1; const float wsel = (hd < 4) ? w0 : w1; const int lb = (hd & 3) * 16;
                    u32x4 va[16]; float wk[16];
#pragma unroll
                    for (int k = 0; k < 16; ++k) {
                        wk[k] = __int_as_float(__builtin_amdgcn_readlane(__float_as_int(wsel), lb + k));
                        const int ek = __builtin_amdgcn_readlane(esel, lb + k);
                        va[k] = *(const u32x4*)(V8 + (size_t)ek * (D / 2) + lane * 16);
                    }
#pragma unroll
                    for (int k = 0; k < 16; ++k) {
                        const _Float16 wh = (_Float16)wk[k]; const h16x2 w2 = (h16x2){wh, wh};
#pragma unroll
                        for (int d = 0; d < 4; ++d) {
                            oo[4 * d + 0] = __builtin_elementwise_fma(CVT4H(va[k][d], 0), w2, oo[4 * d + 0]);
                            oo[4 * d + 1] = __builtin_elementwise_fma(CVT4H(va[k][d], 1), w2, oo[4 * d + 1]);
                            oo[4 * d + 2] = __builtin_elementwise_fma(CVT4H(va[k][d], 2), w2, oo[4 * d + 2]);
                            oo[4 * d + 3] = __builtin_elementwise_fma(CVT4H(va[k][d], 3), w2, oo[4 * d + 3]);
                        }
                    }
                }
                const bool lat = r < RL;
                float* xr = XC + (size_t)(lat ? 0 : r - RL) * D + lane * 32;
                u16* xb = XB + (size_t)(lat ? r : 0) * D + lane * 32;
                const u16* pvec = (const u16*)(ws + WS_PERM) + (size_t)bb * 6144 + lane * 8;
#define PV4(V, q4) ([&]() { const u32x4 t_ = (V)[(q4) >> 1]; const unsigned a_ = ((q4) & 1) ? t_[2] : t_[0], b_ = ((q4) & 1) ? t_[3] : t_[1]; return make_float4(bflo(a_), bfhi(a_), bflo(b_), bfhi(b_)); }())
                u32x4 gv0[4], gv1[4], gv2[4];
#pragma unroll
                for (int k2 = 0; k2 < 4; ++k2) { gv0[k2] = *(const u32x4*)(pvec + k2 * 512); gv1[k2] = *(const u32x4*)(pvec + 2048 + k2 * 512); gv2[k2] = (l == 0) ? *(const u32x4*)(pvec + 4096 + k2 * 512) : gv1[k2]; }
                float4 xv[8]; float ss = 0.f;
                if (lat) {
#pragma unroll
                    for (int c = 0; c < 4; ++c) { const u32x4 t = *(const u32x4*)(xb + c * 8); const unsigned t0 = t[0], t1 = t[1], t2 = t[2], t3 = t[3];
                        xv[2 * c] = make_float4(bflo(t0), bfhi(t0), bflo(t1), bfhi(t1)); xv[2 * c + 1] = make_float4(bflo(t2), bfhi(t2), bflo(t3), bfhi(t3)); }
                } else {
#pragma unroll
                    for (int q4 = 0; q4 < 8; ++q4) xv[q4] = *(const float4*)(xr + q4 * 4);
                }
#pragma unroll
                for (int q4 = 0; q4 < 8; ++q4) {
                    float4 x = xv[q4]; const float4 gg = PV4(gv0, q4);
                    x.x += gg.x * (float)oo[2 * q4][0] * (1.f / PEER_VSC); x.y += gg.y * (float)oo[2 * q4][1] * (1.f / PEER_VSC); x.z += gg.z * (float)oo[2 * q4 + 1][0] * (1.f / PEER_VSC); x.w += gg.w * (float)oo[2 * q4 + 1][1] * (1.f / PEER_VSC);
                    xv[q4] = x; ss += x.x * x.x + x.y * x.y + x.z * x.z + x.w * x.w;
                }
#pragma unroll
                for (int of = 32; of > 0; of >>= 1) ss += __shfl_xor(ss, of);
                const float inv = rsqrtf(ss * (1.f / 2048.f) + 1e-6f);
                if (l == 0) {
                    unsigned* ho = (unsigned*)((unsigned char*)Hb + (size_t)r * D + lane * 32);
                    if (lat) {
#pragma unroll
                        for (int c = 0; c < 4; ++c) { u32x4 t; t[0] = cvtpk(xv[2 * c].x, xv[2 * c].y); t[1] = cvtpk(xv[2 * c].z, xv[2 * c].w); t[2] = cvtpk(xv[2 * c + 1].x, xv[2 * c + 1].y); t[3] = cvtpk(xv[2 * c + 1].z, xv[2 * c + 1].w);
                            *(u32x4*)(xb + c * 8) = t; }
                    } else {
#pragma unroll
                        for (int q4 = 0; q4 < 8; ++q4) *(float4*)(xr + q4 * 4) = xv[q4];
                    }
                    unsigned hq[8], h4q[4];
#pragma unroll
                    for (int q4 = 0; q4 < 8; ++q4) {
                        const float4 ga = PV4(gv1, q4), sh = PV4(gv2, q4);
                        const float y0 = xv[q4].x * inv * ga.x + sh.x, y1 = xv[q4].y * inv * ga.y + sh.y, y2 = xv[q4].z * inv * ga.z + sh.z, y3 = xv[q4].w * inv * ga.w + sh.w;
                        hq[q4] = pack4f8(y0, y1, y2, y3);
                        unsigned f4;
                        if ((q4 & 1) == 0) { f4 = __builtin_amdgcn_cvt_scalef32_pk_fp4_f32(0u, y0 * G4_HS, y1 * G4_HS, 1.0f, 0); f4 = __builtin_amdgcn_cvt_scalef32_pk_fp4_f32(f4, y2 * G4_HS, y3 * G4_HS, 1.0f, 1); }
                        else { f4 = __builtin_amdgcn_cvt_scalef32_pk_fp4_f32(h4q[q4 >> 1], y0 * G4_HS, y1 * G4_HS, 1.0f, 2); f4 = __builtin_amdgcn_cvt_scalef32_pk_fp4_f32(f4, y2 * G4_HS, y3 * G4_HS, 1.0f, 3); }
                        h4q[q4 >> 1] = f4;
                    }
                    if (GATES_FP4) *(u32x4*)(ws + WS_H4 + (size_t)r * 1024 + lane * 16) = (u32x4){h4q[0], h4q[1], h4q[2], h4q[3]};
                    *(u32x4*)(ho) = (u32x4){hq[0], hq[1], hq[2], hq[3]}; *(u32x4*)(ho + 4) = (u32x4){hq[4], hq[5], hq[6], hq[7]};
                } else {
                    float* ob = (float*)lds + (size_t)wave * (64 * 36);
#pragma unroll
                    for (int q4 = 0; q4 < 8; ++q4) { const float4 gn = PV4(gv1, q4);
                        *(float4*)(ob + lane * 36 + q4 * 4) = make_float4(xv[q4].x * inv * gn.x, xv[q4].y * inv * gn.y, xv[q4].z * inv * gn.z, xv[q4].w * inv * gn.w); }
                    float* op = p.out + (size_t)r * D + lane * 4;
#pragma unroll
                    for (int k = 0; k < 8; ++k) {
                        *(float4*)(op + k * 256) = *(const float4*)(ob + (k * 8 + (lane >> 3)) * 36 + (lane & 7) * 4); }
                }
            }
            PH_SEAM(P0 + 13);
        }
    }

}

extern "C" void kernel_launch(void* const* d_in, const int* in_sizes, int n_in, void* d_out, int out_size, void* d_ws, size_t ws_size, hipStream_t stream) {
    static int grid = 0;
    if (grid == 0) {
        if (n_in != 34 || out_size != RL * D || ws_size < WS_END) { fprintf(stderr, "kernel_launch: unexpected shapes (n_in %d out %d ws %zu need %zu)\n", n_in, out_size, ws_size, (size_t)WS_END); grid = -1; return; }
        int dev = 0, cus = 0;
        if (hipGetDevice(&dev) != hipSuccess || hipDeviceGetAttribute(&cus, hipDeviceAttributeMultiprocessorCount, dev) != hipSuccess) { grid = -1; return; }
        if (hipFuncSetAttribute((const void*)fwd_kernel, hipFuncAttributeMaxDynamicSharedMemorySize, LDS_BYTES) != hipSuccess) { fprintf(stderr, "kernel_launch: hipFuncSetAttribute failed\n"); grid = -1; return; }
        int per_cu = 0;
        if (hipOccupancyMaxActiveBlocksPerMultiprocessor(&per_cu, (const void*)fwd_kernel, 512, LDS_BYTES) != hipSuccess || per_cu < 1) { fprintf(stderr, "kernel_launch: occupancy query says %d\n", per_cu); }
        (void)hipGetLastError();
        grid = cus;
    }
    if (grid < 0) return;
    (void)hipMemsetAsync((char*)d_ws + WS_CTL, 0, 16384, stream);
    Params p{};
    for (int i = 0; i < 34; ++i) p.in[i] = (const float*)d_in[i];
    p.out = (float*)d_out; p.ws = (unsigned char*)d_ws;
#if ONE_LAUNCH
    p.ph_lo = 0; p.ph_hi = NPHASE;
    hipLaunchKernelGGL(fwd_kernel, dim3(grid), dim3(512), LDS_BYTES, stream, p);
#else
    for (int ph = 0; ph < NPHASE; ++ph) { p.ph_lo = ph; p.ph_hi = ph + 1; hipLaunchKernelGGL(fwd_kernel, dim3(grid), dim3(512), LDS_BYTES, stream, p); }
#endif
}
```
